# Optimizing an MI355X kernel written in HIP

```python
import math
import jax, jax.numpy as jnp
from jax import lax
import numpy as np

D_MODEL = 1024
BATCH = 4
SEQ = 4096
DEPTH = 2

SSM_WIDTH = D_MODEL // 2
SSM_GROUP = 16
SSM_GROUPS = SSM_WIDTH // SSM_GROUP
SSM_STATE = 64
SSM_DT_MIN = 1e-3
SSM_DT_MAX = 1e-1

RET_HEADS = 4
RET_QK_DIM = D_MODEL // 16
RET_V_DIM = 2 * RET_QK_DIM
RET_QK_WIDTH = RET_HEADS * RET_QK_DIM
RET_V_WIDTH = RET_HEADS * RET_V_DIM
RET_CHUNK = 128
RET_THETA = 10000.0

ATT_HEADS = 8
ATT_HEAD_DIM = 64
ATT_WIDTH = ATT_HEADS * ATT_HEAD_DIM
MOBA_BLOCK = 256
MOBA_TOPK = 3
ATT_Q_CHUNK = 128
ROPE_THETA = 500000.0
ROPE_DIM = ATT_HEAD_DIM // 4

N_BRANCH = 3
FFN_HIDDEN = 2816
CONV_WIDTH = 3
NORM_EPS = 1e-6
NEG_INF = -1e30

IN_SPLITS = [SSM_WIDTH, RET_QK_WIDTH, RET_QK_WIDTH, RET_V_WIDTH, RET_V_WIDTH,
             ATT_WIDTH, ATT_WIDTH, ATT_WIDTH, N_BRANCH * D_MODEL]
N_IN = sum(IN_SPLITS)

kernel_name = "hybrid_s5_retention_moba_convffn"


def rmsnorm(x, g):
    xf = x.astype(jnp.float32)
    r = xf * lax.rsqrt(jnp.mean(xf * xf, axis=-1, keepdims=True) + NORM_EPS)
    return (r * g.astype(jnp.float32)).astype(x.dtype)


def rotary(x, inv_freq):
    L = x.shape[1]
    half = inv_freq.shape[0]
    ang = jnp.arange(L, dtype=jnp.float32)[:, None] * inv_freq[None, :]
    cos = jnp.cos(ang)[None, :, None, :].astype(x.dtype)
    sin = jnp.sin(ang)[None, :, None, :].astype(x.dtype)
    x1 = x[..., :half]
    x2 = x[..., half:2 * half]
    rest = x[..., 2 * half:]
    return jnp.concatenate([x1 * cos - x2 * sin, x1 * sin + x2 * cos, rest], axis=-1)


def s5_branch(u, lam_re, lam_im, log_dt, b_re, b_im, c_re, c_im, d_skip, w_glu):
    bsz, L, _ = u.shape
    f32 = jnp.float32
    uf = u.astype(f32).reshape(bsz, L, SSM_GROUPS, SSM_GROUP)
    lam = lax.complex(lam_re.astype(f32), lam_im.astype(f32))
    dt = jnp.exp(log_dt.astype(f32))[:, None]
    lam_bar = jnp.exp(lam * dt)
    b = lax.complex(b_re.astype(f32), b_im.astype(f32))
    b_bar = ((lam_bar - 1.0) / lam)[..., None] * b
    bu = jnp.einsum('gph,blgh->blgp', b_bar, uf.astype(jnp.complex64))
    a = jnp.broadcast_to(lam_bar, bu.shape)

    def combine(e1, e2):
        a1, s1 = e1
        a2, s2 = e2
        return a1 * a2, a2 * s1 + s2

    _, states = lax.associative_scan(combine, (a, bu), axis=1)
    c = lax.complex(c_re.astype(f32), c_im.astype(f32))
    y = jnp.einsum('ghp,blgp->blgh', c, states).real \
        + d_skip.astype(f32).reshape(SSM_GROUPS, SSM_GROUP) * uf
    y = jax.nn.gelu(y.reshape(bsz, L, SSM_WIDTH))
    out = y * jax.nn.sigmoid(y @ w_glu.astype(f32))
    return out.astype(u.dtype)


def retention_branch(q, k, v, g, gn_g):
    bsz, L = q.shape[:2]
    f32 = jnp.float32
    C = RET_CHUNK
    n_chunks = L // C
    half = RET_QK_DIM // 2
    inv = 1.0 / (RET_THETA ** jnp.linspace(0.0, 1.0, half, dtype=f32))
    q = rotary(q, inv).astype(f32)
    k = rotary(k, inv).astype(f32) * (RET_QK_DIM ** -0.5)
    qc = q.reshape(bsz, n_chunks, C, RET_HEADS, RET_QK_DIM)
    kc = k.reshape(bsz, n_chunks, C, RET_HEADS, RET_QK_DIM)
    vc = v.astype(f32).reshape(bsz, n_chunks, C, RET_HEADS, RET_V_DIM)

    log_gamma = jnp.log1p(-jnp.exp2(-5.0 - jnp.arange(RET_HEADS, dtype=f32)))
    pos = jnp.arange(C, dtype=f32)
    rel = pos[:, None] - pos[None, :]
    decay = jnp.where(rel >= 0,
                      jnp.exp(log_gamma[:, None, None] * jnp.maximum(rel, 0.0)[None]),
                      0.0)
    s = jnp.einsum('bnchd,bnmhd->bnhcm', qc, kc) * decay
    o_intra = jnp.einsum('bnhcm,bnmhe->bnche', s, vc)
    zeta = jnp.exp(log_gamma[:, None] * (C - 1.0 - pos)[None, :])
    kv = jnp.einsum('bnmhd,bnmhe,hm->nbhde', kc, vc, zeta)
    chunk_decay = jnp.exp(log_gamma * C)[None, :, None, None]

    def step(state, kv_n):
        return chunk_decay * state + kv_n, state

    _, state_prev = lax.scan(step, jnp.zeros_like(kv[0]), kv)
    xi = jnp.exp(log_gamma[:, None] * (pos + 1.0)[None, :])
    o_cross = jnp.einsum('bnchd,nbhde,hc->bnche', qc, state_prev, xi)
    o = (o_intra + o_cross).reshape(bsz, L, RET_HEADS, RET_V_DIM)
    mu = jnp.mean(o, axis=-1, keepdims=True)
    var = jnp.mean(jnp.square(o - mu), axis=-1, keepdims=True)
    o = ((o - mu) * lax.rsqrt(var + NORM_EPS)).reshape(bsz, L, RET_V_WIDTH) * gn_g.astype(f32)
    return (jax.nn.silu(g.astype(f32)) * o).astype(g.dtype)


def moba_branch(q, k, v, qn_g, kn_g):
    bsz, L = q.shape[:2]
    out_dtype = q.dtype
    f32 = jnp.float32
    H, hd, BLK, QC = ATT_HEADS, ATT_HEAD_DIM, MOBA_BLOCK, ATT_Q_CHUNK
    q = rmsnorm(q, qn_g)
    k = rmsnorm(k, kn_g)
    rh = ROPE_DIM // 2
    inv = ROPE_THETA ** (-jnp.arange(rh, dtype=f32) / rh)
    q = rotary(q, inv)
    k = rotary(k, inv)

    nb = -(-L // BLK)
    Lp = nb * BLK
    pad = ((0, 0), (0, Lp - L), (0, 0), (0, 0))
    q = jnp.pad(q, pad).astype(f32).transpose(0, 2, 1, 3)
    k = jnp.pad(k, pad).astype(f32).transpose(0, 2, 1, 3)
    v = jnp.pad(v, pad).astype(f32).transpose(0, 2, 1, 3)
    kb = k.reshape(bsz, H, nb, BLK, hd)
    vb = v.reshape(bsz, H, nb, BLK, hd)
    scale = hd ** -0.5
    n_sel = min(MOBA_TOPK, nb - 1)
    nq = Lp // QC
    qc = q.reshape(bsz, H, nq, QC, hd).transpose(2, 0, 1, 3, 4)
    bi = jnp.arange(bsz)[:, None, None, None]
    hi = jnp.arange(H)[None, :, None, None]

    if n_sel > 0:
        k_mean = jnp.mean(kb, axis=3)
        qblk = jnp.arange(Lp) // BLK
        gate = jnp.einsum('bhtd,bhjd->bhtj', q, k_mean)
        past = jnp.arange(nb)[None, :] < qblk[:, None]
        gate = jnp.where(past, gate, NEG_INF)
        _, top_idx = lax.top_k(gate, n_sel)
        top_ok = top_idx < qblk[None, None, :, None]
        sel_c = top_idx.reshape(bsz, H, nq, QC, n_sel).transpose(2, 0, 1, 3, 4)
        ok_c = top_ok.reshape(bsz, H, nq, QC, n_sel).transpose(2, 0, 1, 3, 4)
    else:
        sel_c = jnp.zeros((nq, bsz, H, QC, 1), jnp.int32)
        ok_c = jnp.zeros((nq, bsz, H, QC, 1), bool)

    def attend(args):
        c, q_blk, sel, ok = args
        t = c * QC + jnp.arange(QC)
        own = (c * QC) // BLK
        k_own = lax.dynamic_index_in_dim(kb, own, axis=2, keepdims=False)
        v_own = lax.dynamic_index_in_dim(vb, own, axis=2, keepdims=False)
        kpos = own * BLK + jnp.arange(BLK)
        s_own = jnp.einsum('bhqd,bhkd->bhqk', q_blk, k_own) * scale
        s_own = jnp.where(kpos[None, :] <= t[:, None], s_own, NEG_INF)
        if n_sel > 0:
            k_sel = kb[bi, hi, sel]
            v_sel = vb[bi, hi, sel].reshape(bsz, H, QC, n_sel * BLK, hd)
            s_sel = jnp.einsum('bhqd,bhqnkd->bhqnk', q_blk, k_sel) * scale
            s_sel = jnp.where(ok[..., None], s_sel, NEG_INF).reshape(bsz, H, QC, n_sel * BLK)
            p = jax.nn.softmax(jnp.concatenate([s_sel, s_own], axis=-1), axis=-1)
            return (jnp.einsum('bhqk,bhqkd->bhqd', p[..., :n_sel * BLK], v_sel)
                    + jnp.einsum('bhqk,bhkd->bhqd', p[..., n_sel * BLK:], v_own))
        p = jax.nn.softmax(s_own, axis=-1)
        return jnp.einsum('bhqk,bhkd->bhqd', p, v_own)

    out = lax.map(attend, (jnp.arange(nq), qc, sel_c, ok_c))
    out = out.transpose(1, 0, 3, 2, 4).reshape(bsz, Lp, H * hd)[:, :L]
    return out.astype(out_dtype)


def conv_ffn(x, w_up, conv_w, conv_b, w_down):
    L = x.shape[1]
    h = x @ w_up
    hp = jnp.pad(h, ((0, 0), (CONV_WIDTH - 1, 0), (0, 0)))
    h = conv_b
    for j in range(CONV_WIDTH):
        h = h + hp[:, j:j + L] * conv_w[j]
    g, u = jnp.split(h, 2, axis=-1)
    return (jax.nn.silu(g) * u) @ w_down


def setup_inputs(seed: int = 0) -> dict:
    key = jax.random.key(seed)
    ks = jax.random.split(key, 24)
    f32 = jnp.float32
    Ld = DEPTH
    G, P, Hs = SSM_GROUPS, SSM_STATE, SSM_GROUP

    def nrm(k, shape, scale):
        return jax.random.normal(k, shape, f32) * scale

    return {
        "x": nrm(ks[0], (BATCH, SEQ, D_MODEL), 1.0),
        "norm1_g": 1.0 + nrm(ks[1], (Ld, D_MODEL), 0.02),
        "w_in": nrm(ks[2], (Ld, D_MODEL, N_IN), D_MODEL ** -0.5),
        "ssm_lambda_re": -0.5 + nrm(ks[3], (Ld, G, P), 0.01),
        "ssm_lambda_im": jnp.pi * jnp.arange(P, dtype=f32)[None, None, :] + nrm(ks[4], (Ld, G, P), 0.01),
        "ssm_log_dt": jax.random.uniform(ks[5], (Ld, G), f32, math.log(SSM_DT_MIN), math.log(SSM_DT_MAX)),
        "ssm_b_re": nrm(ks[6], (Ld, G, P, Hs), (2 * Hs) ** -0.5),
        "ssm_b_im": nrm(ks[7], (Ld, G, P, Hs), (2 * Hs) ** -0.5),
        "ssm_c_re": nrm(ks[8], (Ld, G, Hs, P), 0.5),
        "ssm_c_im": nrm(ks[9], (Ld, G, Hs, P), 0.5),
        "ssm_d": nrm(ks[10], (Ld, SSM_WIDTH), 1.0),
        "ssm_w_glu": nrm(ks[11], (Ld, SSM_WIDTH, SSM_WIDTH), SSM_WIDTH ** -0.5),
        "ret_gn_g": 1.0 + nrm(ks[12], (Ld, RET_V_WIDTH), 0.02),
        "attn_qn_g": 1.0 + nrm(ks[13], (Ld, ATT_HEAD_DIM), 0.02),
        "attn_kn_g": 1.0 + nrm(ks[14], (Ld, ATT_HEAD_DIM), 0.02),
        "w_br_ssm": nrm(ks[15], (Ld, SSM_WIDTH, D_MODEL), SSM_WIDTH ** -0.5),
        "w_br_ret": nrm(ks[16], (Ld, RET_V_WIDTH, D_MODEL), RET_V_WIDTH ** -0.5),
        "w_br_att": nrm(ks[17], (Ld, ATT_WIDTH, D_MODEL), ATT_WIDTH ** -0.5),
        "w_o": nrm(ks[18], (Ld, D_MODEL, D_MODEL), D_MODEL ** -0.5),
        "norm2_g": 1.0 + nrm(ks[19], (Ld, D_MODEL), 0.02),
        "ffn_w_up": nrm(ks[20], (Ld, D_MODEL, 2 * FFN_HIDDEN), D_MODEL ** -0.5),
        "ffn_conv_w": nrm(ks[21], (Ld, CONV_WIDTH, 2 * FFN_HIDDEN), CONV_WIDTH ** -0.5),
        "ffn_conv_b": nrm(ks[22], (Ld, 2 * FFN_HIDDEN), 0.01),
        "ffn_w_down": nrm(ks[23], (Ld, FFN_HIDDEN, D_MODEL), FFN_HIDDEN ** -0.5),
    }


def reference(x, norm1_g, w_in, ssm_lambda_re, ssm_lambda_im, ssm_log_dt, ssm_b_re, ssm_b_im,
              ssm_c_re, ssm_c_im, ssm_d, ssm_w_glu, ret_gn_g, attn_qn_g, attn_kn_g,
              w_br_ssm, w_br_ret, w_br_att, w_o, norm2_g, ffn_w_up, ffn_conv_w, ffn_conv_b,
              ffn_w_down):
    bsz, L, _ = x.shape
    offsets = [int(o) for o in np.cumsum(IN_SPLITS)[:-1]]
    for l in range(DEPTH):
        xn = rmsnorm(x, norm1_g[l])
        proj = xn @ w_in[l]
        (u_s, q_r, k_r, v_r, g_r, q_a, k_a, v_a, gates) = jnp.split(proj, offsets, axis=-1)
        y_s = s5_branch(u_s, ssm_lambda_re[l], ssm_lambda_im[l], ssm_log_dt[l], ssm_b_re[l],
                        ssm_b_im[l], ssm_c_re[l], ssm_c_im[l], ssm_d[l], ssm_w_glu[l])
        y_r = retention_branch(q_r.reshape(bsz, L, RET_HEADS, RET_QK_DIM),
                               k_r.reshape(bsz, L, RET_HEADS, RET_QK_DIM),
                               v_r.reshape(bsz, L, RET_HEADS, RET_V_DIM),
                               g_r, ret_gn_g[l])
        y_a = moba_branch(q_a.reshape(bsz, L, ATT_HEADS, ATT_HEAD_DIM),
                          k_a.reshape(bsz, L, ATT_HEADS, ATT_HEAD_DIM),
                          v_a.reshape(bsz, L, ATT_HEADS, ATT_HEAD_DIM),
                          attn_qn_g[l], attn_kn_g[l])
        g_s, g_rt, g_at = jnp.split(jax.nn.sigmoid(gates), N_BRANCH, axis=-1)
        merged = (g_s * (y_s @ w_br_ssm[l]) + g_rt * (y_r @ w_br_ret[l])
                  + g_at * (y_a @ w_br_att[l]))
        x = x + merged @ w_o[l]
        x = x + conv_ffn(rmsnorm(x, norm2_g[l]), ffn_w_up[l], ffn_conv_w[l], ffn_conv_b[l],
                         ffn_w_down[l])
    return x
```

```cpp
#include <hip/hip_runtime.h>
#include <hip/hip_cooperative_groups.h>
#include <cstdint>
#include <cstdio>
namespace cg = cooperative_groups;

#ifndef MEGA
#define MEGA 1
#endif
#ifndef NO_CG
#define NO_CG 1
#endif
#ifndef TIMING
#define TIMING 1
#endif
#ifndef STRAIGHT
#define STRAIGHT 1
#endif


#define LAS __attribute__((address_space(3)))
typedef unsigned short bf16_t;
typedef short bf16x8 __attribute__((ext_vector_type(8)));
typedef float f32x4 __attribute__((ext_vector_type(4)));
typedef float f32x2 __attribute__((ext_vector_type(2)));
typedef unsigned u32x4 __attribute__((ext_vector_type(4)));
typedef unsigned u32x2 __attribute__((ext_vector_type(2)));

constexpr int SEQ = 4096, DM = 1024, MTOK = 16384;
constexpr int NNG = 3584;
constexpr int C_US = 0, C_QR = 512, C_KR = 768, C_VR = 1024, C_GR = 1536, C_QA = 2048, C_KA = 2560, C_VA = 3072;
constexpr int NGATE = 3072, NIN = 6656, FFH = 2816, FF2 = 5632;
constexpr int NWAVES = 8, NTHREADS = 512;
constexpr float NORM_EPS = 1e-6f;

constexpr size_t MiB = 1u << 20;
constexpr size_t WS_SSQ = 256 * 1024;
constexpr size_t WS_KMEAN = 512 * 1024;
constexpr size_t WS_B = 1 * MiB;
constexpr size_t WB_WIN = 0, WB_WGLU = (size_t)NIN * 1024, WB_WBR = WB_WGLU + 512 * 512, WB_WO = WB_WBR + (size_t)1024 * 1536;
constexpr size_t WS_C = 20 * MiB;
constexpr size_t WS_D = 52 * MiB;
constexpr size_t WS_E = 164 * MiB;
constexpr size_t WS_F = 212 * MiB;
constexpr size_t WS_G = 228 * MiB;
constexpr size_t WS_FFW = 236 * MiB + 512 * 1024;
constexpr size_t WG_WUP = 0, WG_WD = (size_t)FF2 * 1024;
constexpr size_t WS_END = 256 * MiB;

__device__ __forceinline__ float bf2f(unsigned short h) { return __uint_as_float((unsigned)h << 16); }
__device__ __forceinline__ float bflo(unsigned w) { return __uint_as_float(w << 16); }
__device__ __forceinline__ float bfhi(unsigned w) { return __uint_as_float(w & 0xffff0000u); }
typedef __bf16 bf16x2_t __attribute__((ext_vector_type(2)));
__device__ __forceinline__ unsigned cvt_pk_bf16(float lo, float hi) { const f32x2 v = {lo, hi}; const bf16x2_t b = __builtin_convertvector(v, bf16x2_t); return __builtin_bit_cast(unsigned, b); }
__device__ __forceinline__ unsigned short f2bf(float f) { return (unsigned short)(cvt_pk_bf16(f, 0.f) & 0xffffu); }
__device__ __forceinline__ float fast_exp(float x) { return __builtin_amdgcn_exp2f(x * 1.4426950408889634f); }
__device__ __forceinline__ float sigmoidf_(float x) { x = fminf(fmaxf(x, -30.f), 30.f); return __builtin_amdgcn_rcpf(1.f + fast_exp(-x)); }
__device__ __forceinline__ float siluf_(float x) { return x * sigmoidf_(x); }
__device__ __forceinline__ float silu_nc(float x) { return x * __builtin_amdgcn_rcpf(1.f + fast_exp(-x)); }
__device__ __forceinline__ float gelu_tanh(float x) {
    const float t = x * fmaf(x * x, -0.10294324f, -2.3022082f);
    return x * __builtin_amdgcn_rcpf(1.f + __builtin_amdgcn_exp2f(t));
}
__device__ __forceinline__ void sincos_red(float a, float& s, float& c) {
    const float k = rintf(a * 0.15915494309189535f);
    float r = fmaf(-k, 6.2831854820251465f, a);
    r = fmaf(-k, -1.7484556000744883e-07f, r);
    s = __sinf(r); c = __cosf(r);
}
__device__ __forceinline__ int lane_id_fresh() { unsigned z = 0u; asm volatile("" : "+s"(z)); return (int)__builtin_amdgcn_mbcnt_hi(~0u, __builtin_amdgcn_mbcnt_lo(~0u, z)); }
template <class T> __device__ __forceinline__ T* at32(T* base, unsigned elem_off) { return (T*)((char*)base + (size_t)(elem_off * (unsigned)sizeof(T))); }
template <class T> __device__ __forceinline__ const T* at32(const T* base, unsigned elem_off) { return (const T*)((const char*)base + (size_t)(elem_off * (unsigned)sizeof(T))); }
__device__ __forceinline__ float readlane_f(float v, int l) { return __int_as_float(__builtin_amdgcn_readlane(__float_as_int(v), l)); }
__device__ __forceinline__ float shx(float v, int m, int lane) { return __int_as_float(__builtin_amdgcn_ds_bpermute((lane ^ m) << 2, __float_as_int(v))); }
__device__ __forceinline__ float wave_sum_l(float v, int lane) {
#pragma unroll
    for (int o = 1; o < 64; o <<= 1) v += shx(v, o, lane);
    return v;
}
__device__ __forceinline__ float wave_sum(float v) {
#pragma unroll
    for (int o = 1; o < 64; o <<= 1) v += __shfl_xor(v, o);
    return v;
}
__device__ __forceinline__ float wave_max(float v) {
#pragma unroll
    for (int o = 1; o < 64; o <<= 1) v = fmaxf(v, __shfl_xor(v, o));
    return v;
}
__device__ __forceinline__ float dpp_ror1(float x) { return __int_as_float(__builtin_amdgcn_mov_dpp(__float_as_int(x), 0x121, 0xF, 0xF, false)); }
__device__ __forceinline__ float dpp_shr1_old(float old, float x) { return __int_as_float(__builtin_amdgcn_update_dpp(__float_as_int(old), __float_as_int(x), 0x111, 0xF, 0xF, false)); }
__device__ __forceinline__ float dpp_shr2_old(float old, float x) { return __int_as_float(__builtin_amdgcn_update_dpp(__float_as_int(old), __float_as_int(x), 0x112, 0xF, 0xF, false)); }
__device__ __forceinline__ float dpp_ror2(float x) { return __int_as_float(__builtin_amdgcn_mov_dpp(__float_as_int(x), 0x122, 0xF, 0xF, false)); }
#define LDS_WAIT() asm volatile("s_waitcnt lgkmcnt(0)" ::: "memory")
#define WG_BAR() do { asm volatile("s_waitcnt lgkmcnt(0)" ::: "memory"); __builtin_amdgcn_s_barrier(); asm volatile("" ::: "memory"); } while (0)

namespace pg8 {
constexpr int BM = 256, BK = 64, HALF = 128, HTB = HALF * BK * 2, STAGE_BYTES = 8 * HTB, NXCD = 8, WGM = 8;
__host__ __device__ __forceinline__ int lds_byte(int r, int c) { const int st = (r >> 4) * 2 + (c >> 5), rr = r & 15, cc = c & 31, ob = rr * 64 + cc * 2; return st * 1024 + (ob ^ (((ob >> 9) & 1) << 5)); }
__host__ __device__ __forceinline__ void stage_rc(int b, int& R, int& C) { const int st = b / 1024, sb = b % 1024, swz = sb ^ (((sb >> 9) & 1) << 5); R = (st >> 1) * 16 + swz / 64; C = (st & 1) * 32 + (swz % 64) / 2; }
__host__ __device__ __forceinline__ int perm32(int rho) { const int n = rho >> 4, i = rho & 15; return 8 * (i >> 2) + 4 * n + (i & 3); }

struct Unit { int pm, pn, aux, nt, asel; long aoff, boff; };
struct ASpec { const bf16_t* A; unsigned rs, ts; };
struct Gemm { ASpec a[2]; const bf16_t* Bt; int ldb; };
__device__ __forceinline__ ASpec rowmajor(const bf16_t* A, int lda) { ASpec a; a.A = A; a.rs = 2u * (unsigned)lda; a.ts = 32u; return a; }
__device__ __forceinline__ Gemm mkgemm(const bf16_t* A, int lda, const bf16_t* Bt, int ldb) { Gemm g; g.a[0] = rowmajor(A, lda); g.a[1] = g.a[0]; g.Bt = Bt; g.ldb = ldb; return g; }

struct StaticOrder {
    int nM, nN, nwg, G, c, nt;
    __device__ __forceinline__ void init(int M, int N, int K, int G_, int c_) { nM = M / BM; nN = N / BM; nwg = nM * nN; G = G_; c = c_; nt = K / BK; }
    __device__ __forceinline__ bool next(int i, Unit& u) const { return map((long)i * G + c, u); }
    __device__ __forceinline__ bool map(long L, Unit& u) const {
        if (L >= nwg) return false;
        int wgid = (int)L; { const int q = nwg / NXCD, r = nwg % NXCD, xcd = wgid % NXCD, off = wgid / NXCD; wgid = (xcd < r ? xcd * (q + 1) : r * (q + 1) + (xcd - r) * q) + off; }
        const int nig = WGM * nN, gid = wgid / nig, fm = gid * WGM, gsz = (nM - fm) < WGM ? (nM - fm) : WGM;
        u.pm = fm + ((wgid % nig) % gsz); u.pn = (wgid % nig) / gsz; u.aux = 0; u.nt = nt; u.asel = 0; u.aoff = 0; u.boff = 0; return true;
    }
};
struct MergeOrder {
    StaticOrder base;
    __device__ __forceinline__ bool next(int i, Unit& u) const { const int r = i / 3, br = i - 3 * r; if (!base.next(r, u)) return false;
        u.aux = br; u.asel = (br == 0) ? 1 : 0; u.aoff = (br == 0) ? 0 : 1024 * br; u.boff = 1024 * br; return true; }
};
struct TileListOrder {
    StaticOrder base; unsigned long long list; int first, stride, count;
    __device__ __forceinline__ void range(int f, int s_, int n) { first = f; stride = s_; count = n; }
    __device__ __forceinline__ bool next(int i, Unit& u) const { if (i >= count || !base.map((long)first + (long)i * stride, u)) return false; u.pn = (int)((list >> (4 * u.pn)) & 15ull); return true; }
};
struct S5P1Order {
    int G, c;
    __device__ __forceinline__ bool next(int i, Unit& u) const { const int L = i * G + c; if (L >= 64) return false; const int g = L >> 1;
        u.pm = L & 1; u.pn = 0; u.aux = g; u.nt = 8; u.asel = 0; u.aoff = (long)g * 512 * NNG * 2; u.boff = (long)g * 128 * 512 * 2; return true; }
};
struct S5P2Order {
    int G, c;
    __device__ __forceinline__ bool next(int i, Unit& u) const { const int r = i >> 1, sub = i & 1; const int L = r * G + c; if (L >= 128) return false; const int g = L >> 2;
        u.pm = (L >> 1) & 1; u.pn = L & 1; u.aux = g * 2 + sub; u.nt = sub ? 2 : 8; u.asel = sub; u.aoff = sub ? 256 * g : (long)g * 512 * NNG * 2; u.boff = ((long)g * 512 * 640 + (sub ? 512 : 0)) * 2; return true; }
};

template <class Epi, class Sched>
__device__ __forceinline__ void gemm_phase(int tid, LAS unsigned char* lds, LAS unsigned char* ldsx, const Gemm g, const Sched& S, const Epi& E) {
    const int wid = __builtin_amdgcn_readfirstlane(tid >> 6), lane = tid & 63, wr = wid >> 2, wc = wid & 3, fr = lane & 15, fq = lane >> 4;
    unsigned voffA0[2], voffA1[2], voffB[2];
#pragma unroll
    for (int i = 0; i < 2; ++i) { int R, C; stage_rc(tid * 16 + i * 8192, R, C); const int Rb = (R & ~31) + perm32(R & 31);
        voffA0[i] = (unsigned)R * g.a[0].rs + (unsigned)(C >> 4) * g.a[0].ts + (unsigned)(C & 15) * 2u;
        voffA1[i] = (unsigned)R * g.a[1].rs + (unsigned)(C >> 4) * g.a[1].ts + (unsigned)(C & 15) * 2u;
        voffB[i] = (unsigned)(Rb * g.ldb + C) * 2u; }
    const size_t kstepB = (size_t)(BK * 2);
    const size_t hstepB = (size_t)HALF * g.ldb * 2, tstepB = 2 * hstepB;
    const unsigned ldsw = (unsigned)wid * 1024u;
    const int aoff = lds_byte(wr * 64 + fr, fq * 8), boff = lds_byte(wc * 32 + fr, fq * 8);
#define PG8_SA(b, h) (((b) * 2 + (h)) * HTB)
#define PG8_SB(b, h) ((4 + (b) * 2 + (h)) * HTB)
#define PG8_STAGE(bufoff, gbase, voff) do { _Pragma("unroll") for (int _i = 0; _i < 2; ++_i) \
        __builtin_amdgcn_global_load_lds((const unsigned*)((const char*)(gbase) + (voff)[_i]), (LAS unsigned*)(lds + (bufoff) + ldsw + _i * 8192), 16, 0, 0); } while (0)
#define PG8_LDA(dst, b, h) do { _Pragma("unroll") for (int m = 0; m < 4; ++m) _Pragma("unroll") for (int k = 0; k < 2; ++k) dst[m][k] = *(const LAS bf16x8*)(lds + PG8_SA(b, h) + aoff + m * 2048 + k * 1024); } while (0)
#define PG8_LDB(dst, b, h) do { _Pragma("unroll") for (int n = 0; n < 2; ++n) _Pragma("unroll") for (int k = 0; k < 2; ++k) dst[n][k] = *(const LAS bf16x8*)(lds + PG8_SB(b, h) + boff + n * 2048 + k * 1024); } while (0)
#define PG8_MMA(ai, bj, At, Bt) do { __builtin_amdgcn_s_setprio(1); _Pragma("unroll") for (int m = 0; m < 4; ++m) _Pragma("unroll") for (int n = 0; n < 2; ++n) _Pragma("unroll") for (int k = 0; k < 2; ++k) \
        acc[ai][bj][m][n] = __builtin_amdgcn_mfma_f32_16x16x32_bf16(Bt[n][k], At[m][k], acc[ai][bj][m][n], 0, 0, 0); __builtin_amdgcn_s_setprio(0); } while (0)
#define PG8_WAIT_V(n) asm volatile("s_waitcnt vmcnt(" #n ")" ::: "memory")
#define PG8_WAIT_L(n) asm volatile("s_waitcnt lgkmcnt(" #n ")" ::: "memory")
#define PG8_BAR __builtin_amdgcn_s_barrier()
#define PG8_SCHED __builtin_amdgcn_sched_barrier(0)
#define PG8_ABASE(u) ((const char*)((u).asel ? g.a[1].A : g.a[0].A) + (size_t)(u).pm * 256u * ((u).asel ? g.a[1].rs : g.a[0].rs) + (size_t)(u).aoff)
#define PG8_BBASE(u) ((const char*)g.Bt + (size_t)(u).pn * tstepB + (size_t)(u).boff)
    Unit cur, nxt; int ui = 0;
    if (!S.next(0, cur)) return;
    f32x4 acc[2][2][4][2];
#pragma unroll
    for (int a = 0; a < 2; ++a)
#pragma unroll
        for (int b = 0; b < 2; ++b)
#pragma unroll
            for (int m = 0; m < 4; ++m)
#pragma unroll
                for (int n = 0; n < 2; ++n) acc[a][b][m][n] = (f32x4){0.f, 0.f, 0.f, 0.f};
    bf16x8 At[4][2], B0[2][2], B1[2][2];
    const char* cA = PG8_ABASE(cur); const char* cB = PG8_BBASE(cur);
    unsigned cvA[2]; cvA[0] = cur.asel ? voffA1[0] : voffA0[0]; cvA[1] = cur.asel ? voffA1[1] : voffA0[1];
    size_t ckA = 4u * (size_t)(cur.asel ? g.a[1].ts : g.a[0].ts), chA = 128u * (size_t)(cur.asel ? g.a[1].rs : g.a[0].rs);
    int cnt = cur.nt;
    PG8_STAGE(PG8_SB(0, 0), cB, voffB); PG8_STAGE(PG8_SB(0, 1), cB + hstepB, voffB); PG8_STAGE(PG8_SA(0, 0), cA, cvA); PG8_STAGE(PG8_SA(0, 1), cA + chA, cvA);
    if (wr == 1) PG8_BAR;
    PG8_WAIT_V(2); PG8_BAR;
    PG8_STAGE(PG8_SB(1, 0), cB + kstepB, voffB); PG8_STAGE(PG8_SA(1, 0), cA + ckA, cvA); PG8_STAGE(PG8_SB(1, 1), cB + hstepB + kstepB, voffB);
    PG8_WAIT_V(6); PG8_BAR;
    for (;;) {
        const bool has_next = S.next(ui + 1, nxt);
        const char* nA = has_next ? PG8_ABASE(nxt) : cA; const char* nB = has_next ? PG8_BBASE(nxt) : cB;
        unsigned nvA[2]; nvA[0] = has_next ? (nxt.asel ? voffA1[0] : voffA0[0]) : cvA[0]; nvA[1] = has_next ? (nxt.asel ? voffA1[1] : voffA0[1]) : cvA[1];
        const size_t nkA = has_next ? 4u * (size_t)(nxt.asel ? g.a[1].ts : g.a[0].ts) : ckA, nhA = has_next ? 128u * (size_t)(nxt.asel ? g.a[1].rs : g.a[0].rs) : chA;
        for (int t = 0; t < cnt; t += 2) {
            const bool last = (t == cnt - 2);
            const char* a1 = cA + (size_t)(t + 1) * ckA;
            const char* a2 = last ? nA : cA + (size_t)(t + 2) * ckA; const char* b2 = last ? nB : cB + (size_t)(t + 2) * kstepB;
            const size_t k2 = last ? nkA : ckA, h2 = last ? nhA : chA;
            unsigned v2[2]; v2[0] = last ? nvA[0] : cvA[0]; v2[1] = last ? nvA[1] : cvA[1];
            const char* a3 = a2 + k2; const char* b3 = b2 + kstepB;
            PG8_LDB(B0, 0, 0); PG8_LDB(B1, 0, 1); PG8_SCHED; PG8_LDA(At, 0, 0); PG8_STAGE(PG8_SA(1, 1), a1 + chA, cvA);
            PG8_WAIT_V(8); PG8_WAIT_L(0); PG8_BAR; PG8_MMA(0, 0, At, B0); PG8_MMA(0, 1, At, B1); PG8_BAR; PG8_SCHED;
            PG8_LDA(At, 0, 1); PG8_STAGE(PG8_SB(0, 0), b2, voffB); PG8_STAGE(PG8_SB(0, 1), b2 + hstepB, voffB); PG8_STAGE(PG8_SA(0, 0), a2, v2);
            PG8_WAIT_V(8); PG8_WAIT_L(0); PG8_BAR; PG8_MMA(1, 0, At, B0); PG8_MMA(1, 1, At, B1); PG8_BAR; PG8_SCHED;
            PG8_LDB(B0, 1, 0); PG8_LDB(B1, 1, 1); PG8_SCHED; PG8_LDA(At, 1, 0); PG8_STAGE(PG8_SA(0, 1), a2 + h2, v2);
            PG8_WAIT_V(8); PG8_WAIT_L(0); PG8_BAR; PG8_MMA(0, 0, At, B0); PG8_MMA(0, 1, At, B1); PG8_BAR; PG8_SCHED;
            PG8_LDA(At, 1, 1); PG8_STAGE(PG8_SB(1, 0), b3, voffB); PG8_STAGE(PG8_SB(1, 1), b3 + hstepB, voffB); PG8_STAGE(PG8_SA(1, 0), a3, v2);
            PG8_WAIT_V(8); PG8_WAIT_L(0); PG8_BAR; PG8_MMA(1, 0, At, B0); PG8_MMA(1, 1, At, B1); PG8_BAR; PG8_SCHED;
        }
        if (wr == 0) PG8_BAR;
        { int ln_ = lane_id_fresh(); asm volatile("" : "+v"(ln_));
          E(acc, cur, wr, wc, ln_ & 15, ln_ >> 4, wid, ln_, ldsx); }
        if (!has_next) break;
        if (!E.keep(cur)) {
#pragma unroll
            for (int a = 0; a < 2; ++a)
#pragma unroll
                for (int b = 0; b < 2; ++b)
#pragma unroll
                    for (int m = 0; m < 4; ++m)
#pragma unroll
                        for (int n = 0; n < 2; ++n) acc[a][b][m][n] = (f32x4){0.f, 0.f, 0.f, 0.f};
        }
        cur = nxt; cA = nA; cB = nB; cvA[0] = nvA[0]; cvA[1] = nvA[1]; ckA = nkA; chA = nhA; cnt = cur.nt; ++ui;
        if (wr == 1) PG8_BAR;
    }
    PG8_WAIT_V(0);
    PG8_BAR;
#undef PG8_ABASE
#undef PG8_BBASE
#undef PG8_SA
#undef PG8_SB
#undef PG8_STAGE
#undef PG8_LDA
#undef PG8_LDB
#undef PG8_MMA
#undef PG8_WAIT_V
#undef PG8_WAIT_L
#undef PG8_BAR
#undef PG8_SCHED
}

typedef f32x4 Acc[2][2][4][2];

struct EpiScaleAct {
    bf16_t* O; int ldc; const float* ssq; int silu_lo, silu_hi, all_sig, us_tiles;
    __device__ __forceinline__ bool keep(const Unit&) const { return false; }
    __device__ __forceinline__ void operator()(Acc& acc, const Unit& u, int wr, int wc, int fr, int fq, int wid, int lane, LAS unsigned char* ldsx) const {
        const int row0 = u.pm * BM + wr * 64 + fr, col0 = u.pn * BM + wc * 32 + 8 * fq;
        const int act = all_sig ? 2 : ((u.pn >= silu_lo && u.pn < silu_hi) ? 1 : 0);
        f32x4 s4[8];
#pragma unroll
        for (int q = 0; q < 8; ++q) s4[q] = *(const f32x4*)(ssq + (size_t)(row0 + (q >> 2) * HALF + (q & 3) * 16) * 4);
        asm volatile("" ::: "memory");
#pragma unroll
        for (int ai = 0; ai < 2; ++ai)
#pragma unroll
            for (int m = 0; m < 4; ++m) {
                const int row = row0 + ai * HALF + m * 16;
                const f32x4 sq = s4[ai * 4 + m];
                const float rs = rsqrtf(((sq.x + sq.y) + (sq.z + sq.w)) * (1.0f / 1024.0f) + NORM_EPS);
#pragma unroll
                for (int bj = 0; bj < 2; ++bj) {
                    f32x4 v0, v1;
                    if (act == 2) {
                        const float rn = rs * -1.4426950408889634f;
#pragma unroll
                        for (int i = 0; i < 4; ++i) { v0[i] = __builtin_amdgcn_exp2f(fminf(acc[ai][bj][m][0][i] * rn, 43.f)); v1[i] = __builtin_amdgcn_exp2f(fminf(acc[ai][bj][m][1][i] * rn, 43.f)); }
                    } else { v0 = acc[ai][bj][m][0] * rs; v1 = acc[ai][bj][m][1] * rs;
                        if (act == 1) { for (int i = 0; i < 4; ++i) { v0[i] = siluf_(v0[i]); v1[i] = siluf_(v1[i]); } } }
                    u32x4 w; w.x = cvt_pk_bf16(v0[0], v0[1]); w.y = cvt_pk_bf16(v0[2], v0[3]); w.z = cvt_pk_bf16(v1[0], v1[1]); w.w = cvt_pk_bf16(v1[2], v1[3]);
                    if (u.pn < us_tiles) { const int ch = col0 + bj * HALF; *(u32x4*)(O + ((size_t)(ch >> 4) * 512 + (row >> 5)) * ldc + (row & 31) * 16 + (ch & 15)) = w; }
                    else *(u32x4*)at32(O, (unsigned)(row * ldc + col0 + bj * HALF)) = w;
                }
                asm volatile("" ::: "memory");
            }
    }
};
template <int KIND  > struct EpiInProj {
    bf16_t* O; const float* ssq; const float* qn; const float* kn; float* KM;
    __device__ __forceinline__ bool keep(const Unit&) const { return false; }
    __device__ __forceinline__ void operator()(Acc& acc, const Unit& u, int wr, int wc, int fr, int fq, int wid, int lane_, LAS unsigned char* ldsx) const {
        int lane = lane_; asm volatile("" : "+v"(lane));
        fq = lane >> 4; fr = lane & 15;
        const int row0 = u.pm * BM + wr * 64 + fr, col0 = u.pn * BM + wc * 32 + 8 * fq;
        const int pn = u.pn;
        f32x4 s4[8];
#pragma unroll
        for (int q = 0; q < 8; ++q) s4[q] = *(const f32x4*)((const char*)ssq + (unsigned)(row0 + (q >> 2) * HALF + (q & 3) * 16) * 16u);
        asm volatile("" ::: "memory");
#pragma unroll
        for (int ai = 0; ai < 2; ++ai)
#pragma unroll
            for (int m = 0; m < 4; ++m) { const f32x4 sq = s4[ai * 4 + m]; const float rs = rsqrtf(((sq.x + sq.y) + (sq.z + sq.w)) * (1.0f / 1024.0f) + NORM_EPS);
#pragma unroll
                for (int bj = 0; bj < 2; ++bj)
#pragma unroll
                    for (int n = 0; n < 2; ++n) acc[ai][bj][m][n] *= rs; }
        constexpr bool qk_ret = (KIND == 1), qk_att = (KIND == 2);
        if constexpr (qk_ret) {
            float inv[8];
#pragma unroll
            for (int e = 0; e < 8; ++e) inv[e] = exp2f(-(float)(8 * fq + e) * (13.287712379549449f / 31.0f));
            const float sc = (pn == 3) ? 0.125f : 1.0f;
#pragma unroll
            for (int ai = 0; ai < 2; ++ai)
#pragma unroll
                for (int m = 0; m < 4; ++m) {
                    const int row = row0 + ai * HALF + m * 16; const float t = (float)(row & (SEQ - 1));
#pragma unroll
                    for (int n = 0; n < 2; ++n) { f32x4 a = acc[ai][0][m][n], b = acc[ai][1][m][n];
#pragma unroll
                        for (int j = 0; j < 4; ++j) { float sn, cs; sincos_red(t * inv[4 * n + j], sn, cs); const float x1 = a[j], x2 = b[j]; a[j] = (x1 * cs - x2 * sn) * sc; b[j] = (x1 * sn + x2 * cs) * sc; }
                        asm volatile("" : "+v"(a), "+v"(b));
                        acc[ai][0][m][n] = a; acc[ai][1][m][n] = b; }
                }
        } else if constexpr (qk_att) {
            const float* gp = ((pn >= 10) ? kn : qn) + 8 * fq;
            const f32x4 g00 = *(const f32x4*)gp, g01 = *(const f32x4*)(gp + 4), g10 = *(const f32x4*)(gp + 32), g11 = *(const f32x4*)(gp + 36);
            float inv[8];
#pragma unroll
            for (int e = 0; e < 8; ++e) inv[e] = exp2f(-(float)e * (18.931568569324174f / 8.0f));
            const float sc = (pn < 10) ? 0.125f * 1.4426950408889634f : 1.0f;
            f32x4 cs0 = (f32x4){0.f, 0.f, 0.f, 0.f}, cs1 = cs0, cs2 = cs0, cs3 = cs0;
#pragma unroll
            for (int ai = 0; ai < 2; ++ai)
#pragma unroll
                for (int m = 0; m < 4; ++m) {
                    const int row = row0 + ai * HALF + m * 16; const float t = (float)(row & (SEQ - 1));
                    f32x4 a0 = acc[ai][0][m][0], a1 = acc[ai][0][m][1], b0 = acc[ai][1][m][0], b1 = acc[ai][1][m][1];
                    float ss = 0.f;
#pragma unroll
                    for (int j = 0; j < 4; ++j) ss += a0[j] * a0[j] + a1[j] * a1[j] + b0[j] * b0[j] + b1[j] * b1[j];
                    ss += shx(ss, 16, lane); ss += shx(ss, 32, lane);
                    const float r2 = rsqrtf(ss * (1.0f / 64.0f) + NORM_EPS);
                    a0 = a0 * r2 * g00; a1 = a1 * r2 * g01; b0 = b0 * r2 * g10; b1 = b1 * r2 * g11;
#pragma unroll
                    for (int n = 0; n < 2; ++n) { f32x4 own = n ? a1 : a0; f32x4 res = own;
#pragma unroll
                        for (int j = 0; j < 4; ++j) { const float oth = shx(own[j], 16, lane); float sn, cs; sincos_red(t * inv[4 * n + j], sn, cs);
                            res[j] = (fq == 0) ? (own[j] * cs - oth * sn) : (oth * sn + own[j] * cs); }
                        if (fq < 2) { if (n) a1 = res; else a0 = res; } }
                    a0 *= sc; a1 *= sc; b0 *= sc; b1 *= sc;
                    cs0 += a0; cs1 += a1; cs2 += b0; cs3 += b1;
                    asm volatile("" : "+v"(a0), "+v"(a1), "+v"(b0), "+v"(b1), "+v"(cs0), "+v"(cs1), "+v"(cs2), "+v"(cs3));
                    acc[ai][0][m][0] = a0; acc[ai][0][m][1] = a1; acc[ai][1][m][0] = b0; acc[ai][1][m][1] = b1;
                }
            if (pn >= 10) {
                float cv[16] = {cs0[0], cs0[1], cs0[2], cs0[3], cs1[0], cs1[1], cs1[2], cs1[3], cs2[0], cs2[1], cs2[2], cs2[3], cs3[0], cs3[1], cs3[2], cs3[3]};
#pragma unroll
                for (int e = 0; e < 16; ++e) { float v = cv[e]; v += shx(v, 1, lane); v += shx(v, 2, lane); v += shx(v, 4, lane); v += shx(v, 8, lane); cv[e] = v; }
                LAS float* R = (LAS float*)ldsx;
                if (fr == 0) {
#pragma unroll
                    for (int e = 0; e < 16; ++e) R[((wr * 4 + wc) * 4 + fq) * 16 + e] = cv[e]; }
                WG_BAR();
                if (wr == 0 && fr == 0) { const int head = 4 * (pn - 10) + wc, b = u.pm >> 4, jb = u.pm & 15;
                    float* km = KM + ((b * 8 + head) * 16 + jb) * 64;
#pragma unroll
                    for (int e = 0; e < 16; ++e) { const float v = (R[((0 * 4 + wc) * 4 + fq) * 16 + e] + R[((1 * 4 + wc) * 4 + fq) * 16 + e]) * (1.0f / 256.0f);
                        km[(e >> 3) * 32 + 8 * fq + (e & 7)] = v; } }
                WG_BAR();
            }
        }
        const int act = (KIND == 0 && (pn == 6 || pn == 7)) ? 1 : 0;
#pragma unroll
        for (int ai = 0; ai < 2; ++ai)
#pragma unroll
            for (int m = 0; m < 4; ++m) {
                const int row = row0 + ai * HALF + m * 16;
#pragma unroll
                for (int bj = 0; bj < 2; ++bj) {
                    f32x4 v0 = acc[ai][bj][m][0], v1 = acc[ai][bj][m][1];
                    if (act == 1) { for (int i = 0; i < 4; ++i) { v0[i] = siluf_(v0[i]); v1[i] = siluf_(v1[i]); } }
                    u32x4 w; w.x = cvt_pk_bf16(v0[0], v0[1]); w.y = cvt_pk_bf16(v0[2], v0[3]); w.z = cvt_pk_bf16(v1[0], v1[1]); w.w = cvt_pk_bf16(v1[2], v1[3]);
                    unsigned off;
                    if (KIND == 0 && pn < 2) { const int ch = col0 + bj * HALF; off = ((unsigned)((ch >> 4) * 512 + (row >> 5)) * NNG + (unsigned)((row & 31) * 16 + (ch & 15))) * 2u; }
                    else if (qk_ret || qk_att) off = ((unsigned)row * NNG + (unsigned)(pn * BM + wc * 64 + bj * 32 + 8 * fq)) * 2u;
                    else off = ((unsigned)row * NNG + (unsigned)(col0 + bj * HALF)) * 2u;
                    *(u32x4*)((char*)O + off) = w;
                }
                asm volatile("" ::: "memory");
            }
    }
};
struct EpiGlu {
    const bf16_t* Y; bf16_t* O;
    __device__ __forceinline__ bool keep(const Unit&) const { return false; }
    __device__ __forceinline__ void operator()(Acc& acc, const Unit& u, int wr, int wc, int fr, int fq, int wid, int lane, LAS unsigned char* ldsx) const {
        const int row0 = u.pm * BM + wr * 64 + fr, col0 = u.pn * BM + wc * 32 + 8 * fq;
        u32x4 yn[2];
#pragma unroll
        for (int bj = 0; bj < 2; ++bj) yn[bj] = *(const u32x4*)at32(Y, (unsigned)(row0 * 1536 + col0 + bj * HALF));
#pragma unroll
        for (int ai = 0; ai < 2; ++ai)
#pragma unroll
            for (int m = 0; m < 4; ++m) {
                const int row = row0 + ai * HALF + m * 16, q = ai * 4 + m;
                u32x4 yc[2]; yc[0] = yn[0]; yc[1] = yn[1];
                if (q < 7) { const int rown = row0 + ((q + 1) >> 2) * HALF + ((q + 1) & 3) * 16;
#pragma unroll
                    for (int bj = 0; bj < 2; ++bj) yn[bj] = *(const u32x4*)at32(Y, (unsigned)(rown * 1536 + col0 + bj * HALF)); }
                asm volatile("" ::: "memory");
#pragma unroll
                for (int bj = 0; bj < 2; ++bj) {
                    const u32x4 y = yc[bj];
                    const f32x4 a0 = acc[ai][bj][m][0], a1 = acc[ai][bj][m][1];
                    u32x4 w;
                    w.x = cvt_pk_bf16(bflo(y.x) * sigmoidf_(a0[0]), bfhi(y.x) * sigmoidf_(a0[1]));
                    w.y = cvt_pk_bf16(bflo(y.y) * sigmoidf_(a0[2]), bfhi(y.y) * sigmoidf_(a0[3]));
                    w.z = cvt_pk_bf16(bflo(y.z) * sigmoidf_(a1[0]), bfhi(y.z) * sigmoidf_(a1[1]));
                    w.w = cvt_pk_bf16(bflo(y.w) * sigmoidf_(a1[2]), bfhi(y.w) * sigmoidf_(a1[3]));
                    *(u32x4*)at32(O, (unsigned)(row * 512 + col0 + bj * HALF)) = w;
                }
                asm volatile("" ::: "memory");
            }
    }
};
struct EpiMerge {
    const bf16_t* G; bf16_t* O;
    __device__ __forceinline__ bool keep(const Unit& u) const { return u.aux < 2; }
    __device__ __forceinline__ void operator()(Acc& acc, const Unit& u, int wr, int wc, int fr, int fq, int wid, int lane, LAS unsigned char* ldsx) const {
        const int row0 = u.pm * BM + wr * 64 + fr, col0 = u.pn * BM + wc * 32 + 8 * fq; const int br = u.aux;
        const bf16_t* gbase = G + 1024 * br + col0;
        u32x4 gcn[2], gnn[2];
#pragma unroll
        for (int bj = 0; bj < 2; ++bj) { gcn[bj] = *(const u32x4*)at32(gbase, (unsigned)(row0 * NGATE + bj * HALF)); gnn[bj] = gcn[bj]; if (br < 2) gnn[bj] = *(const u32x4*)at32(gbase, (unsigned)(row0 * NGATE + bj * HALF + 1024)); }
#pragma unroll
        for (int ai = 0; ai < 2; ++ai)
#pragma unroll
            for (int m = 0; m < 4; ++m) {
                const int row = row0 + ai * HALF + m * 16, q = ai * 4 + m;
                u32x4 gcc[2], gnc[2]; gcc[0] = gcn[0]; gcc[1] = gcn[1]; gnc[0] = gnn[0]; gnc[1] = gnn[1];
                if (q < 7) { const size_t rown = (size_t)(row0 + ((q + 1) >> 2) * HALF + ((q + 1) & 3) * 16);
#pragma unroll
                    for (int bj = 0; bj < 2; ++bj) { gcn[bj] = *(const u32x4*)at32(gbase, (unsigned)rown * NGATE + bj * HALF); if (br < 2) gnn[bj] = *(const u32x4*)at32(gbase, (unsigned)rown * NGATE + bj * HALF + 1024); } }
                asm volatile("" ::: "memory");
#pragma unroll
                for (int bj = 0; bj < 2; ++bj) {
                    const u32x4 gc = gcc[bj];
                    float f[8] = {bflo(gc.x), bfhi(gc.x), bflo(gc.y), bfhi(gc.y), bflo(gc.z), bfhi(gc.z), bflo(gc.w), bfhi(gc.w)};
                    if (br < 2) {
                        const u32x4 gn = gnc[bj];
                        const float d[8] = {bflo(gn.x), bfhi(gn.x), bflo(gn.y), bfhi(gn.y), bflo(gn.z), bfhi(gn.z), bflo(gn.w), bfhi(gn.w)};
#pragma unroll
                        for (int i = 0; i < 8; ++i) f[i] = (1.f + d[i]) * __builtin_amdgcn_rcpf(1.f + f[i]);
                    } else {
#pragma unroll
                        for (int i = 0; i < 8; ++i) f[i] = __builtin_amdgcn_rcpf(1.f + f[i]);
                    }
                    f32x4 v0 = acc[ai][bj][m][0], v1 = acc[ai][bj][m][1];
#pragma unroll
                    for (int i = 0; i < 4; ++i) { v0[i] *= f[i]; v1[i] *= f[4 + i]; }
                    if (br < 2) { acc[ai][bj][m][0] = v0; acc[ai][bj][m][1] = v1; }
                    else { u32x4 w; w.x = cvt_pk_bf16(v0[0], v0[1]); w.y = cvt_pk_bf16(v0[2], v0[3]); w.z = cvt_pk_bf16(v1[0], v1[1]); w.w = cvt_pk_bf16(v1[2], v1[3]);
                        *(u32x4*)at32(O, (unsigned)(row * 1024 + col0 + bj * HALF)) = w; }
                }
            }
    }
};
struct EpiResid {
    const float* Xin; float* X; bf16_t* XB; float* ssq; int dry;
    __device__ __forceinline__ bool keep(const Unit&) const { return false; }
    __device__ __forceinline__ void operator()(Acc& acc, const Unit& u, int wr, int wc, int fr, int fq, int wid, int lane, LAS unsigned char* ldsx) const {
        const int row0 = u.pm * BM + wr * 64 + fr, col0 = u.pn * BM + wc * 32 + 8 * fq;
        LAS float* P = (LAS float*)ldsx;
        f32x4 xn[2][2];
#pragma unroll
        for (int bj = 0; bj < 2; ++bj) { const float* xp = at32(Xin, (unsigned)(row0 * 1024 + col0 + bj * HALF)); xn[bj][0] = *(const f32x4*)xp; xn[bj][1] = *(const f32x4*)(xp + 4); }
#pragma unroll
        for (int ai = 0; ai < 2; ++ai)
#pragma unroll
            for (int m = 0; m < 4; ++m) {
                const int row = row0 + ai * HALF + m * 16, q = ai * 4 + m; float sq = 0.f;
                f32x4 xc[2][2]; xc[0][0] = xn[0][0]; xc[0][1] = xn[0][1]; xc[1][0] = xn[1][0]; xc[1][1] = xn[1][1];
                if (q < 7) { const size_t rown = (size_t)(row0 + ((q + 1) >> 2) * HALF + ((q + 1) & 3) * 16);
#pragma unroll
                    for (int bj = 0; bj < 2; ++bj) { const float* xp = at32(Xin, (unsigned)rown * 1024 + col0 + bj * HALF); xn[bj][0] = *(const f32x4*)xp; xn[bj][1] = *(const f32x4*)(xp + 4); } }
                asm volatile("" ::: "memory");
#pragma unroll
                for (int bj = 0; bj < 2; ++bj) {
                    float* xp = at32(X, (unsigned)(row * 1024 + col0 + bj * HALF));
                    const f32x4 v0 = xc[bj][0] + acc[ai][bj][m][0], v1 = xc[bj][1] + acc[ai][bj][m][1];
                    if (!dry) { *(f32x4*)xp = v0; *(f32x4*)(xp + 4) = v1; }
                    sq += (v0[0] * v0[0] + v0[1] * v0[1]) + (v0[2] * v0[2] + v0[3] * v0[3]) + (v1[0] * v1[0] + v1[1] * v1[1]) + (v1[2] * v1[2] + v1[3] * v1[3]);
                    if (XB && !dry) { u32x4 w; w.x = cvt_pk_bf16(v0[0], v0[1]); w.y = cvt_pk_bf16(v0[2], v0[3]); w.z = cvt_pk_bf16(v1[0], v1[1]); w.w = cvt_pk_bf16(v1[2], v1[3]);
                        *(u32x4*)at32(XB, (unsigned)(row * 1024 + col0 + bj * HALF)) = w; }
                }
                sq += shx(sq, 16, lane); sq += shx(sq, 32, lane);
                if (fq == 0) P[(ai * HALF + wr * 64 + m * 16 + fr) * 4 + wc] = sq;
            }
        WG_BAR();
        const int tid_ = wid * 64 + lane;
        if (ssq && !dry && tid_ < 256) { const f32x4 p = *(const LAS f32x4*)(P + tid_ * 4); ssq[(size_t)(u.pm * BM + tid_) * 4 + u.pn] = (p.x + p.y) + (p.z + p.w); }
        WG_BAR();
    }
};
struct EpiFfnUp {
    bf16_t* ACT; const float* ssq; const float* cw; const float* cb; float* head; float* tail; int dry;
    __device__ __forceinline__ bool keep(const Unit&) const { return false; }
    __device__ __forceinline__ void operator()(Acc& acc, const Unit& u, int wr, int wc, int fr, int fq, int wid, int lane, LAS unsigned char* ldsx) const {
        if (dry) return;
        LAS float* XBf = (LAS float*)ldsx;
        const int row0 = u.pm * BM + wr * 64 + fr, cl = wc * 32 + 8 * fq;
        f32x4 cwn[4];
        {
            f32x4 s4[8];
#pragma unroll
            for (int q = 0; q < 8; ++q) s4[q] = *(const f32x4*)(ssq + (size_t)(row0 + (q >> 2) * HALF + (q & 3) * 16) * 4);
            { const int wcol = u.pn * HALF + cl;
              cwn[0] = *(const f32x4*)(cw + wcol); cwn[1] = *(const f32x4*)(cw + FF2 + wcol); cwn[2] = *(const f32x4*)(cw + 2 * FF2 + wcol); cwn[3] = *(const f32x4*)(cb + wcol); }
            asm volatile("" ::: "memory");
#pragma unroll
            for (int ai = 0; ai < 2; ++ai)
#pragma unroll
                for (int m = 0; m < 4; ++m) {
                    const f32x4 sq = s4[ai * 4 + m];
                    const float rs = rsqrtf(((sq.x + sq.y) + (sq.z + sq.w)) * (1.0f / 1024.0f) + NORM_EPS);
#pragma unroll
                    for (int bj = 0; bj < 2; ++bj)
#pragma unroll
                        for (int n = 0; n < 2; ++n) acc[ai][bj][m][n] *= rs;
                }
        }
        if (fr >= 14) {
#pragma unroll
            for (int ai = 0; ai < 2; ++ai)
#pragma unroll
                for (int bj = 0; bj < 2; ++bj)
#pragma unroll
                    for (int n = 0; n < 2; ++n) *(LAS f32x4*)(XBf + ((ai * 2 + wr) * 2 + (fr - 14)) * 256 + bj * HALF + cl + 4 * n) = acc[ai][bj][3][n];
            if (wr == 1) {
#pragma unroll
                for (int bj = 0; bj < 2; ++bj)
#pragma unroll
                    for (int n = 0; n < 2; ++n) *(f32x4*)(tail + (size_t)(u.pm * 2 + (fr - 14)) * FF2 + u.pn * BM + bj * HALF + cl + 4 * n) = acc[1][bj][3][n];
            }
        }
        if (wr == 0 && fr < 2) {
#pragma unroll
            for (int bj = 0; bj < 2; ++bj)
#pragma unroll
                for (int n = 0; n < 2; ++n) *(f32x4*)(head + (size_t)(u.pm * 2 + fr) * FF2 + u.pn * BM + bj * HALF + cl + 4 * n) = acc[0][bj][0][n];
        }
        WG_BAR();
#pragma unroll
        for (int bj = 0; bj < 2; ++bj)
#pragma unroll
            for (int n = 0; n < 2; ++n) {
                const f32x4 w0 = cwn[0], w1 = cwn[1], w2 = cwn[2], bb = cwn[3];
                if (bj * 2 + n < 3) { const int gq = bj * 2 + n + 1; const int wcol = (gq >> 1) * FFH + u.pn * HALF + cl + 4 * (gq & 1);
                    cwn[0] = *(const f32x4*)(cw + wcol); cwn[1] = *(const f32x4*)(cw + FF2 + wcol); cwn[2] = *(const f32x4*)(cw + 2 * FF2 + wcol); cwn[3] = *(const f32x4*)(cb + wcol); }
                asm volatile("" ::: "memory");
#pragma unroll
                for (int ai = 0; ai < 2; ++ai) {
                    const int s = ai * 2 + wr;
                    f32x4 pv = *(const LAS f32x4*)(XBf + ((s > 0 ? s - 1 : 0) * 2 + (fr & 1)) * 256 + bj * HALF + cl + 4 * n);
                    if (s == 0) pv = (f32x4){0.f, 0.f, 0.f, 0.f};
#pragma unroll
                    for (int m = 3; m >= 0; --m) {
                        const f32x4 prev = (m > 0) ? acc[ai][bj][m - 1][n] : pv;
                        const f32x4 c4 = acc[ai][bj][m][n]; f32x4 o4;
#pragma unroll
                        for (int i = 0; i < 4; ++i) {
                            const float cur = c4[i], p = prev[i];
                            const float h1 = dpp_shr1_old(dpp_ror1(p), cur), h2 = dpp_shr2_old(dpp_ror2(p), cur);
                            o4[i] = bb[i] + w0[i] * h2 + w1[i] * h1 + w2[i] * cur;
                        }
                        asm volatile("" : "+v"(o4));
                        acc[ai][bj][m][n] = o4;
                    }
                }
                asm volatile("" ::: "memory");
            }
#pragma unroll
        for (int ai = 0; ai < 2; ++ai)
#pragma unroll
            for (int m = 0; m < 4; ++m) {
                const int row = row0 + ai * HALF + m * 16;
                const f32x4 g0 = acc[ai][0][m][0], g1 = acc[ai][0][m][1], u0 = acc[ai][1][m][0], u1 = acc[ai][1][m][1];
                u32x4 w; w.x = cvt_pk_bf16(silu_nc(g0[0]) * u0[0], silu_nc(g0[1]) * u0[1]); w.y = cvt_pk_bf16(silu_nc(g0[2]) * u0[2], silu_nc(g0[3]) * u0[3]);
                w.z = cvt_pk_bf16(silu_nc(g1[0]) * u1[0], silu_nc(g1[1]) * u1[1]); w.w = cvt_pk_bf16(silu_nc(g1[2]) * u1[2], silu_nc(g1[3]) * u1[3]);
                *(u32x4*)at32(ACT, (unsigned)(row * FFH + u.pn * HALF + cl)) = w;
                asm volatile("" ::: "memory");
            }
        WG_BAR();
    }
};
struct EpiS5P1 {
    bf16_t* SN;
    __device__ __forceinline__ bool keep(const Unit&) const { return false; }
    __device__ __forceinline__ void operator()(Acc& acc, const Unit& u, int wr, int wc, int fr, int fq, int wid, int lane, LAS unsigned char* ldsx) const {
        const int row0 = u.pm * BM + wr * 64 + fr, g = u.aux;
#pragma unroll
        for (int ai = 0; ai < 2; ++ai)
#pragma unroll
            for (int m = 0; m < 4; ++m) {
                const int R = row0 + ai * HALF + m * 16;
                const f32x4 v0 = acc[ai][0][m][0], v1 = acc[ai][0][m][1];
                u32x4 w; w.x = cvt_pk_bf16(v0[0], v0[1]); w.y = cvt_pk_bf16(v0[2], v0[3]); w.z = cvt_pk_bf16(v1[0], v1[1]); w.w = cvt_pk_bf16(v1[2], v1[3]);
                *(u32x4*)(SN + ((size_t)R * 32 + g) * 128 + wc * 32 + 8 * fq) = w;
            }
    }
};
struct EpiS5P2 {
    const bf16_t* U; const float* dsk; bf16_t* Y;
    __device__ __forceinline__ bool keep(const Unit& u) const { return !(u.aux & 1); }
    __device__ __forceinline__ void operator()(Acc& acc, const Unit& u, int wr, int wc, int fr, int fq, int wid, int lane, LAS unsigned char* ldsx) const {
        if (!(u.aux & 1)) return;
        int fq_ = fq; asm volatile("" : "+v"(fq_));
        const int row0 = u.pm * BM + wr * 64 + fr, g = u.aux >> 1, h0 = 8 * (fq_ & 1);
        const f32x4 d0 = *(const f32x4*)(dsk + g * 16 + h0), d1 = *(const f32x4*)(dsk + g * 16 + h0 + 4);
#pragma unroll
        for (int ai = 0; ai < 2; ++ai)
#pragma unroll
            for (int m = 0; m < 4; ++m) {
                const int R = row0 + ai * HALF + m * 16;
#pragma unroll
                for (int bj = 0; bj < 2; ++bj) {
                    const int t = 16 * u.pn + 8 * bj + 2 * wc + (fq_ >> 1);
                    const size_t token = (size_t)R * 32 + t;
                    const u32x4 uu = *(const u32x4*)(U + ((size_t)g * 512 + R) * NNG + t * 16 + h0);
                    const f32x4 a0 = acc[ai][bj][m][0], a1 = acc[ai][bj][m][1];
                    u32x4 w;
                    w.x = cvt_pk_bf16(gelu_tanh(a0[0] + d0[0] * bflo(uu.x)), gelu_tanh(a0[1] + d0[1] * bfhi(uu.x)));
                    w.y = cvt_pk_bf16(gelu_tanh(a0[2] + d0[2] * bflo(uu.y)), gelu_tanh(a0[3] + d0[3] * bfhi(uu.y)));
                    w.z = cvt_pk_bf16(gelu_tanh(a1[0] + d1[0] * bflo(uu.z)), gelu_tanh(a1[1] + d1[1] * bfhi(uu.z)));
                    w.w = cvt_pk_bf16(gelu_tanh(a1[2] + d1[2] * bflo(uu.w)), gelu_tanh(a1[3] + d1[3] * bfhi(uu.w)));
                    *(u32x4*)(Y + token * 1536 + g * 16 + h0) = w;
                }
                asm volatile("" ::: "memory");
            }
    }
};
}

struct Args { const float* in[24]; float* out; unsigned char* ws; int ph_lo, ph_hi, sub, pad; };

typedef const __attribute__((address_space(4))) struct Args CArgs;
struct Ctx {
    LAS unsigned char* lds; LAS unsigned char* ldsx;
    int tid, lane, wave, G, blk;
    CArgs* ka; float* out; unsigned char* ws;
};
constexpr int RING_BYTES = 131072, LDSX_BYTES = 16384, LDS_BYTES = RING_BYTES + LDSX_BYTES;

__device__ __forceinline__ void transpose_item(const float* W, int N, const float* gk, bf16_t* WT, int ldd, int koff, int drow0, int dstep, LAS float* scr, int k0, int n0, int lane) {
    constexpr int ST = 66;
    f32x4 v[16];
#pragma unroll
    for (int i = 0; i < 16; ++i) v[i] = *(const f32x4*)(W + (size_t)(k0 + 4 * i + (lane >> 4)) * N + n0 + 4 * (lane & 15));
#pragma unroll
    for (int i = 0; i < 16; ++i) { const int kk = 4 * i + (lane >> 4); f32x4 x = v[i]; if (gk) x *= gk[k0 + kk];
        LAS f32x2* d = (LAS f32x2*)(scr + kk * ST + 4 * (lane & 15)); d[0] = (f32x2){x.x, x.y}; d[1] = (f32x2){x.z, x.w}; }
    LDS_WAIT(); asm volatile("" ::: "memory");
    const int c = lane & 7;
#pragma unroll
    for (int j = 0; j < 8; ++j) { const int n = (lane >> 3) + 8 * j; const LAS float* s = scr + (8 * c) * ST + n;
        u32x4 o; o.x = cvt_pk_bf16(s[0 * ST], s[1 * ST]); o.y = cvt_pk_bf16(s[2 * ST], s[3 * ST]); o.z = cvt_pk_bf16(s[4 * ST], s[5 * ST]); o.w = cvt_pk_bf16(s[6 * ST], s[7 * ST]);
        *(u32x4*)(WT + (size_t)(drow0 + (n & 31) + (n >> 5) * dstep) * ldd + koff + k0 + 8 * c) = o; }
    LDS_WAIT(); asm volatile("" ::: "memory");
}
__device__ __forceinline__ void convert_matrix(const Ctx& C, const float* W, int K, int N, const float* gk, bf16_t* WT, int ldd, int koff, int rowmode) {
    LAS float* scr = (LAS float*)(C.lds + __builtin_amdgcn_readfirstlane(C.tid >> 6) * 17408);
    const int gw = C.blk * NWAVES + __builtin_amdgcn_readfirstlane(C.tid >> 6), NGW = C.G * NWAVES;
    const int nblk = N / 64, items = (K / 64) * nblk;
    for (int it = gw; it < items; it += NGW) {
        const int kb = it / nblk, nb = it - kb * nblk, n0 = nb * 64;
        int drow0 = n0, dstep = 32;
        if (rowmode == 1) drow0 = (n0 < FFH) ? ((n0 >> 7) * 256 + (n0 & 127)) : (((n0 - FFH) >> 7) * 256 + 128 + ((n0 - FFH) & 127));
        if (rowmode == 2) { const int tile = n0 >> 8;
            if (tile == 2 || tile == 3 || (tile >= 8 && tile <= 11)) { drow0 = tile * 256 + 32 * ((n0 >> 6) & 3); dstep = 128; } }
        transpose_item(W, N, gk, WT, ldd, koff, drow0, dstep, scr, kb * 64, n0, (C.tid & 63));
    }
}

__device__ __forceinline__ void phase_prologue(const Ctx& C) {
    const int gw = C.blk * NWAVES + __builtin_amdgcn_readfirstlane(C.tid >> 6), NGW = C.G * NWAVES;
    const float* x = C.ka->in[0]; bf16_t* xb = (bf16_t*)(C.ws + WS_C); float* ssq = (float*)(C.ws + WS_SSQ);
    for (int r = gw; r < MTOK; r += NGW) {
        const f32x4* xr = (const f32x4*)(x + (size_t)r * DM) + (C.tid & 63);
        u32x2* brow = (u32x2*)(xb + (size_t)r * DM) + (C.tid & 63);
        f32x4 v[4];
#pragma unroll
        for (int j = 0; j < 4; ++j) v[j] = xr[64 * j];
        float s[4];
#pragma unroll
        for (int j = 0; j < 4; ++j) { u32x2 w; w.x = cvt_pk_bf16(v[j].x, v[j].y); w.y = cvt_pk_bf16(v[j].z, v[j].w); brow[64 * j] = w;
            s[j] = wave_sum_l((v[j].x * v[j].x + v[j].y * v[j].y) + (v[j].z * v[j].z + v[j].w * v[j].w), (C.tid & 63)); }
        if ((C.tid & 63) == 0) *(f32x4*)(ssq + (size_t)r * 4) = (f32x4){s[0], s[1], s[2], s[3]};
    }
}
__device__ __forceinline__ void phase_conv_a(const Ctx& C, int l) {
    bf16_t* WB = (bf16_t*)(C.ws + WS_B);
    LAS float* scr = (LAS float*)(C.lds + __builtin_amdgcn_readfirstlane(C.tid >> 6) * 17408);
    const int gw = C.blk * NWAVES + __builtin_amdgcn_readfirstlane(C.tid >> 6), NGW = C.G * NWAVES;
    for (int it = gw; it < 2368; it += NGW) {
        int j = it, m = 0;
        if (j >= 2112) { m = 5; j -= 2112; } else if (j >= 1728) { j -= 1728; m = 2 + (j >> 7); j &= 127; } else if (j >= 1664) { m = 1; j -= 1664; }
        const int N = (m == 0) ? NIN : (m == 1) ? 512 : 1024, nblk = N >> 6;
        const int inidx = (m == 0) ? 2 : (m == 1) ? 11 : (m == 5) ? 18 : 13 + m;
        const size_t lsz = (m == 0) ? (size_t)1024 * NIN : (m == 1) ? (size_t)512 * 512 : (m == 5) ? (size_t)1024 * 1024 : (size_t)512 * 1024;
        const float* W = C.ka->in[inidx] + (size_t)l * lsz;
        bf16_t* WT = WB + ((m == 0) ? WB_WIN : (m == 1) ? WB_WGLU : (m == 5) ? WB_WO : WB_WBR);
        const int ldd = (m == 1) ? 512 : (m >= 2 && m <= 4) ? 1536 : 1024, koff = (m >= 2 && m <= 4) ? 512 * (m - 2) : 0;
        const float* gk = (m == 0) ? C.ka->in[1] + l * 1024 : nullptr;
        const int kb = j / nblk, nb = j - kb * nblk, n0 = nb * 64;
        int drow0 = n0, dstep = 32;
        if (m == 0) { const int tile = n0 >> 8;
            if (tile == 2 || tile == 3 || (tile >= 8 && tile <= 11)) { drow0 = tile * 256 + 32 * ((n0 >> 6) & 3); dstep = 128; } }
        transpose_item(W, N, gk, WT, ldd, koff, drow0, dstep, scr, kb * 64, n0, (C.tid & 63));
    }
}
__device__ __forceinline__ void phase_conv_b(const Ctx& C, int l) {
    bf16_t* WG = (bf16_t*)(C.ws + WS_FFW);
    convert_matrix(C, C.ka->in[20] + (size_t)l * 1024 * FF2, 1024, FF2, C.ka->in[19] + l * 1024, WG + WG_WUP, 1024, 0, 1);
    convert_matrix(C, C.ka->in[23] + (size_t)l * FFH * 1024, FFH, 1024, nullptr, WG + WG_WD, FFH, 0, 0);
}

__device__ __forceinline__ void phase_mix1(const Ctx& C, int l) {
    const int gw = C.blk * NWAVES + __builtin_amdgcn_readfirstlane(C.tid >> 6), NGW = C.G * NWAVES, lane = (C.tid & 63);
    bf16_t* P = (bf16_t*)(C.ws + WS_D);
    const float* qn = C.ka->in[13] + l * 64; const float* kn = C.ka->in[14] + l * 64;
    for (int r = gw; r < MTOK; r += NGW) {
        const float t = (float)(r & (SEQ - 1));
        bf16_t* row = P + (size_t)r * NNG;
#pragma unroll
        for (int jj = 0; jj < 2; ++jj) {
            const int p = lane + 64 * jj, h = p >> 5, i = p & 31;
            const float inv = exp2f(-(float)i * (13.287712379549449f / 31.0f));
            float sn, cs; sincos_red(t * inv, sn, cs);
            bf16_t* q = row + C_QR + h * 64 + i; bf16_t* k = row + C_KR + h * 64 + i;
            const float q1 = bf2f(q[0]), q2 = bf2f(q[32]), k1 = bf2f(k[0]), k2 = bf2f(k[32]);
            q[0] = f2bf(q1 * cs - q2 * sn); q[32] = f2bf(q1 * sn + q2 * cs);
            k[0] = f2bf((k1 * cs - k2 * sn) * 0.125f); k[32] = f2bf((k1 * sn + k2 * cs) * 0.125f);
        }
        {
            const int which = lane >> 5, h = (lane >> 2) & 7, qt = lane & 3;
            bf16_t* p = row + (which ? C_KA : C_QA) + h * 64 + qt * 16;
            const float* gg = (which ? kn : qn) + qt * 16;
            const u32x4 a = *(const u32x4*)p, b = *(const u32x4*)(p + 8);
            float v[16] = {bflo(a.x), bfhi(a.x), bflo(a.y), bfhi(a.y), bflo(a.z), bfhi(a.z), bflo(a.w), bfhi(a.w), bflo(b.x), bfhi(b.x), bflo(b.y), bfhi(b.y), bflo(b.z), bfhi(b.z), bflo(b.w), bfhi(b.w)};
            float s = 0.f;
#pragma unroll
            for (int i = 0; i < 16; ++i) s += v[i] * v[i];
            s += shx(s, 1, lane); s += shx(s, 2, lane);
            const float rs = rsqrtf(s * (1.0f / 64.0f) + NORM_EPS);
#pragma unroll
            for (int i = 0; i < 16; ++i) v[i] = v[i] * rs * gg[i];
            const float qsc = which ? 1.0f : 0.125f * 1.4426950408889634f;
            if (qt == 0) {
#pragma unroll
                for (int i = 0; i < 8; ++i) {
                    const float inv = exp2f(-(float)i * (18.931568569324174f / 8.0f));
                    float sn, cs; sincos_red(t * inv, sn, cs);
                    const float x1 = v[i], x2 = v[i + 8];
                    v[i] = x1 * cs - x2 * sn; v[i + 8] = x1 * sn + x2 * cs;
                }
            }
#pragma unroll
            for (int i = 0; i < 16; ++i) v[i] *= qsc;
            u32x4 oa, ob;
            oa.x = cvt_pk_bf16(v[0], v[1]); oa.y = cvt_pk_bf16(v[2], v[3]); oa.z = cvt_pk_bf16(v[4], v[5]); oa.w = cvt_pk_bf16(v[6], v[7]);
            ob.x = cvt_pk_bf16(v[8], v[9]); ob.y = cvt_pk_bf16(v[10], v[11]); ob.z = cvt_pk_bf16(v[12], v[13]); ob.w = cvt_pk_bf16(v[14], v[15]);
            *(u32x4*)p = oa; *(u32x4*)(p + 8) = ob;
        }
    }
}

__device__ __forceinline__ void s5_naive_unit(const Ctx& C, int l, int b, int g) {
    const int lane = (C.tid & 63), p = lane, hl = lane & 15;
    const bf16_t* P = (const bf16_t*)(C.ws + WS_D); bf16_t* Y = (bf16_t*)(C.ws + WS_F);
    const float lre = C.ka->in[3][(l * 32 + g) * 64 + p], lim = C.ka->in[4][(l * 32 + g) * 64 + p], dt = expf(C.ka->in[5][l * 32 + g]);
    const float er = expf(lre * dt); float sn, cs; sincos_red(lim * dt, sn, cs);
    const float lbr = er * cs, lbi = er * sn;
    const float nr = lbr - 1.f, ni = lbi, den = lre * lre + lim * lim;
    const float cr = (nr * lre + ni * lim) / den, ci = (ni * lre - nr * lim) / den;
    float bbr[16], bbi[16], ccr[16], cci[16];
#pragma unroll
    for (int h = 0; h < 16; ++h) {
        const float br = C.ka->in[6][((size_t)(l * 32 + g) * 64 + p) * 16 + h], bi = C.ka->in[7][((size_t)(l * 32 + g) * 64 + p) * 16 + h];
        bbr[h] = cr * br - ci * bi; bbi[h] = cr * bi + ci * br;
        ccr[h] = C.ka->in[8][((size_t)(l * 32 + g) * 16 + h) * 64 + p]; cci[h] = C.ka->in[9][((size_t)(l * 32 + g) * 16 + h) * 64 + p];
    }
    const float dsk = C.ka->in[10][l * 512 + g * 16 + hl];
    float sr = 0.f, si = 0.f;
    const bf16_t* ubase = P + ((size_t)g * 512 + b * 128) * NNG + C_US + hl;
    float unext[4];
#pragma unroll
    for (int j = 0; j < 4; ++j) { const int tt = 4 * j + (lane >> 4); unext[j] = bf2f(ubase[(size_t)(tt >> 5) * NNG + (tt & 31) * 16]); }
    for (int t0 = 0; t0 < SEQ; t0 += 16) {
        float ucur[4];
#pragma unroll
        for (int j = 0; j < 4; ++j) ucur[j] = unext[j];
        if (t0 + 16 < SEQ) {
#pragma unroll
            for (int j = 0; j < 4; ++j) { const int tt = t0 + 16 + 4 * j + (lane >> 4); unext[j] = bf2f(ubase[(size_t)(tt >> 5) * NNG + (tt & 31) * 16]); }
        }
#pragma unroll
        for (int sj = 0; sj < 4; ++sj) {
          const float ureg = ucur[sj];
#pragma unroll 1
          for (int ss = 0; ss < 4; ++ss) {
            const int s = sj * 4 + ss;
            float bur = 0.f, bui = 0.f;
#pragma unroll
            for (int h = 0; h < 16; ++h) { const float uh = readlane_f(ureg, ss * 16 + h); bur = fmaf(bbr[h], uh, bur); bui = fmaf(bbi[h], uh, bui); }
            const float nsr = lbr * sr - lbi * si + bur, nsi = lbr * si + lbi * sr + bui;
            sr = nsr; si = nsi;
            float z[16];
#pragma unroll
            for (int h = 0; h < 16; ++h) z[h] = ccr[h] * sr - cci[h] * si;
            float w8[8], w4[4], w2[2], w1;
            { const bool hi = lane & 1;
#pragma unroll
              for (int j = 0; j < 8; ++j) { const float keep = hi ? z[2 * j + 1] : z[2 * j], send = hi ? z[2 * j] : z[2 * j + 1]; w8[j] = keep + __shfl_xor(send, 1); } }
            { const bool hi = lane & 2;
#pragma unroll
              for (int j = 0; j < 4; ++j) { const float keep = hi ? w8[2 * j + 1] : w8[2 * j], send = hi ? w8[2 * j] : w8[2 * j + 1]; w4[j] = keep + __shfl_xor(send, 2); } }
            { const bool hi = lane & 4;
#pragma unroll
              for (int j = 0; j < 2; ++j) { const float keep = hi ? w4[2 * j + 1] : w4[2 * j], send = hi ? w4[2 * j] : w4[2 * j + 1]; w2[j] = keep + __shfl_xor(send, 4); } }
            { const bool hi = lane & 8; const float keep = hi ? w2[1] : w2[0], send = hi ? w2[0] : w2[1]; w1 = keep + __shfl_xor(send, 8); }
            w1 += __shfl_xor(w1, 16); w1 += __shfl_xor(w1, 32);
            const float ul = __shfl(ureg, ss * 16 + hl);
            const float y = w1 + dsk * ul;
#ifdef DBG_CMP_S5
            if (lane < 16 && b == 0 && t0 + s < 3072) ((bf16_t*)(C.ws + WS_G + 25 * MiB))[(size_t)(t0 + s) * 512 + g * 16 + lane] = f2bf(gelu_tanh(y));
#else
            if (lane < 16) Y[(size_t)(b * SEQ + t0 + s) * 512 + g * 16 + lane] = f2bf(gelu_tanh(y));
#endif
          }
        }
    }
}
__device__ __forceinline__ void ret_naive_unit(const Ctx& C, int b, int h, int eh) {
    const int lane = (C.tid & 63), e = eh * 64 + lane;
    const bf16_t* P = (const bf16_t*)(C.ws + WS_D); bf16_t* O = (bf16_t*)(C.ws + WS_G);
    const float gamma = 1.f - exp2f(-5.f - (float)h);
    float S[64];
#pragma unroll
    for (int d = 0; d < 64; ++d) S[d] = 0.f;
    const bf16_t* base = P + (size_t)b * SEQ * NNG;
    float qn[4], kn[4], vn[4];
#pragma unroll
    for (int j = 0; j < 4; ++j) { const bf16_t* r = base + (size_t)j * NNG; qn[j] = bf2f(r[C_QR + h * 64 + lane]); kn[j] = bf2f(r[C_KR + h * 64 + lane]); vn[j] = bf2f(r[C_VR + h * 128 + e]); }
    for (int t0 = 0; t0 < SEQ; t0 += 4) {
        float qc[4], kc[4], vc[4];
#pragma unroll
        for (int j = 0; j < 4; ++j) { qc[j] = qn[j]; kc[j] = kn[j]; vc[j] = vn[j]; }
        if (t0 + 4 < SEQ) {
#pragma unroll
            for (int j = 0; j < 4; ++j) { const bf16_t* r = base + (size_t)(t0 + 4 + j) * NNG; qn[j] = bf2f(r[C_QR + h * 64 + lane]); kn[j] = bf2f(r[C_KR + h * 64 + lane]); vn[j] = bf2f(r[C_VR + h * 128 + e]); }
        }
#pragma unroll
        for (int j = 0; j < 4; ++j) {
            float o = 0.f;
#pragma unroll
            for (int d = 0; d < 64; ++d) {
                const float kd = readlane_f(kc[j], d), qd = readlane_f(qc[j], d);
                S[d] = fmaf(gamma, S[d], kd * vc[j]);
                o = fmaf(qd, S[d], o);
            }
            O[(size_t)(b * SEQ + t0 + j) * 512 + h * 128 + e] = f2bf(o);
        }
    }
}
__device__ __forceinline__ void kmean_unit(const Ctx& C, int b, int h, int j) {
    const bf16_t* P = (const bf16_t*)(C.ws + WS_D); float* KM = (float*)(C.ws + WS_KMEAN);
    const bf16_t* kp = P + (size_t)(b * SEQ + j * 256) * NNG + C_KA + h * 64 + (C.tid & 63);
    float s0 = 0.f, s1 = 0.f, s2 = 0.f, s3 = 0.f;
#pragma unroll 8
    for (int i = 0; i < 256; i += 4) { s0 += bf2f(kp[(size_t)i * NNG]); s1 += bf2f(kp[(size_t)(i + 1) * NNG]); s2 += bf2f(kp[(size_t)(i + 2) * NNG]); s3 += bf2f(kp[(size_t)(i + 3) * NNG]); }
    KM[((b * 8 + h) * 16 + j) * 64 + (C.tid & 63)] = ((s0 + s1) + (s2 + s3)) * (1.0f / 256.0f);
}
__device__ __forceinline__ void phase_mix2(const Ctx& C, int l) {
    const int gw = __builtin_amdgcn_readfirstlane(C.tid >> 6) * C.G + C.blk, NGW = C.G * NWAVES;
    (void)NGW;
    const int u = gw;
    if (u < 128) s5_naive_unit(C, l, u >> 5, u & 31);
    else if (u < 160) { const int v = u - 128; ret_naive_unit(C, v >> 3, (v >> 1) & 3, v & 1); }
    else if (u < 672) { const int v = u - 160; kmean_unit(C, v >> 7, (v >> 4) & 7, v & 15); }
}
__device__ __forceinline__ void ret_finalize_row(const Ctx& C, int l, int r) {
    const int lane = (C.tid & 63), h = lane >> 4, e0 = (lane & 15) * 8;
    const bf16_t* O = (const bf16_t*)(C.ws + WS_G); const bf16_t* P = (const bf16_t*)(C.ws + WS_D); bf16_t* Y = (bf16_t*)(C.ws + WS_E);
    const u32x4 a = *(const u32x4*)(O + (size_t)r * 512 + h * 128 + e0);
    float v[8] = {bflo(a.x), bfhi(a.x), bflo(a.y), bfhi(a.y), bflo(a.z), bfhi(a.z), bflo(a.w), bfhi(a.w)};
    float s = 0.f;
#pragma unroll
    for (int i = 0; i < 8; ++i) s += v[i];
    s += __shfl_xor(s, 1); s += __shfl_xor(s, 2); s += __shfl_xor(s, 4); s += __shfl_xor(s, 8);
    const float mu = s * (1.0f / 128.0f); float q = 0.f;
#pragma unroll
    for (int i = 0; i < 8; ++i) { v[i] -= mu; q += v[i] * v[i]; }
    q += __shfl_xor(q, 1); q += __shfl_xor(q, 2); q += __shfl_xor(q, 4); q += __shfl_xor(q, 8);
    const float rs = rsqrtf(q * (1.0f / 128.0f) + NORM_EPS);
    const u32x4 gsil = *(const u32x4*)(P + (size_t)r * NNG + C_GR + h * 128 + e0);
    const float gs[8] = {bflo(gsil.x), bfhi(gsil.x), bflo(gsil.y), bfhi(gsil.y), bflo(gsil.z), bfhi(gsil.z), bflo(gsil.w), bfhi(gsil.w)};
    const float* gn = C.ka->in[12] + l * 512 + h * 128 + e0;
    float o[8];
#pragma unroll
    for (int i = 0; i < 8; ++i) o[i] = gs[i] * (v[i] * rs * gn[i]);
    u32x4 w; w.x = cvt_pk_bf16(o[0], o[1]); w.y = cvt_pk_bf16(o[2], o[3]); w.z = cvt_pk_bf16(o[4], o[5]); w.w = cvt_pk_bf16(o[6], o[7]);
#ifdef DBG_CMP_RET
    if (r < 3072) *(u32x4*)((bf16_t*)(C.ws + WS_G + 25 * MiB) + (size_t)r * 512 + h * 128 + e0) = w;
#else
    *(u32x4*)(Y + (size_t)r * 1536 + 512 + h * 128 + e0) = w;
#endif
}
__device__ __forceinline__ void moba_naive_query(const Ctx& C, int b, int h, int t) {
    const int lane = (C.tid & 63);
    const bf16_t* P = (const bf16_t*)(C.ws + WS_D); const float* KM = (const float*)(C.ws + WS_KMEAN); bf16_t* Y = (bf16_t*)(C.ws + WS_E);
    const size_t rowq = (size_t)(b * SEQ + t);
    const float qv = bf2f(P[rowq * NNG + C_QA + h * 64 + lane]);
    float q[64];
#pragma unroll
    for (int d = 0; d < 64; ++d) q[d] = readlane_f(qv, d);
    const int qblk = t >> 8;
    float gate = -3.0e38f;
    if (lane < 16) {
        const float* km = KM + ((b * 8 + h) * 16 + lane) * 64; float s = 0.f;
#pragma unroll
        for (int d = 0; d < 64; d += 4) { const f32x4 k4 = *(const f32x4*)(km + d); s += q[d] * k4.x + q[d + 1] * k4.y + q[d + 2] * k4.z + q[d + 3] * k4.w; }
        if (lane < qblk) gate = s;
    }
    int segblk[4]; const int nsel = qblk < 3 ? qblk : 3;
#pragma unroll
    for (int s = 0; s < 3; ++s) {
        segblk[s] = 0;
        if (s < nsel) {
            const float mx = wave_max(gate);
            const unsigned long long bal = __ballot(gate == mx && lane < 16);
            const int j = (int)__builtin_ctzll(bal);
            segblk[s] = j;
            if (lane == j) gate = -3.0e38f;
        }
    }
    segblk[3] = qblk;
    float sc[16]; float mx = -3.0e38f;
#pragma unroll
    for (int s = 0; s < 4; ++s) {
        const bool segon = (s == 3) || (s < nsel);
#pragma unroll
        for (int i = 0; i < 4; ++i) {
            float v = -3.0e38f;
            if (segon) {
                const int key = segblk[s] * 256 + 64 * i + lane;
                if (s < 3 || key <= t) {
                    const bf16_t* kp = P + (size_t)(b * SEQ + key) * NNG + C_KA + h * 64; float a = 0.f;
#pragma unroll
                    for (int d = 0; d < 64; d += 8) { const u32x4 k8 = *(const u32x4*)(kp + d);
                        a += q[d] * bflo(k8.x) + q[d + 1] * bfhi(k8.x) + q[d + 2] * bflo(k8.y) + q[d + 3] * bfhi(k8.y) + q[d + 4] * bflo(k8.z) + q[d + 5] * bfhi(k8.z) + q[d + 6] * bflo(k8.w) + q[d + 7] * bfhi(k8.w); }
                    v = a;
                }
            }
            sc[s * 4 + i] = v; mx = fmaxf(mx, v);
        }
    }
    mx = wave_max(mx);
    float sum = 0.f;
#pragma unroll
    for (int i = 0; i < 16; ++i) { sc[i] = (sc[i] > -1.0e38f) ? __builtin_amdgcn_exp2f(sc[i] - mx) : 0.f; sum += sc[i]; }
    sum = wave_sum(sum);
    float o = 0.f;
#pragma unroll
    for (int s = 0; s < 4; ++s) {
        const bool segon = (s == 3) || (s < nsel);
        if (segon) {
#pragma unroll
            for (int i = 0; i < 4; ++i) {
                const bf16_t* vp = P + (size_t)(b * SEQ + segblk[s] * 256 + 64 * i) * NNG + C_VA + h * 64 + lane;
                const float pr = sc[s * 4 + i];
#pragma unroll 8
                for (int kk = 0; kk < 64; ++kk) { const float pk = __shfl(pr, kk); o = fmaf(pk, bf2f(vp[(size_t)kk * NNG]), o); }
            }
        }
    }
#ifdef DBG_CMP_MOBA
    ((bf16_t*)(C.ws + WS_G + 17 * MiB))[rowq * 512 + h * 64 + lane] = f2bf(o / sum);
#else
    Y[rowq * 1536 + 1024 + h * 64 + lane] = f2bf(o / sum);
#endif
}
__device__ __forceinline__ void phase_mix3(const Ctx& C, int l) {
    const int gw = C.blk * NWAVES + __builtin_amdgcn_readfirstlane(C.tid >> 6), NGW = C.G * NWAVES;
    for (int r = gw; r < MTOK; r += NGW) ret_finalize_row(C, l, r);
#ifdef NAIVE_MOBA
    for (int u = gw; u < MTOK * 8; u += NGW) { const int h = u & 7, row = u >> 3; moba_naive_query(C, row >> 12, h, row & (SEQ - 1)); }
#endif
}
__device__ __forceinline__ void phase_fixup(const Ctx& C, int l) {
    const float* head = (const float*)(C.ws + WS_C); const float* tail = head + (size_t)64 * 2 * FF2;
    bf16_t* ACT = (bf16_t*)(C.ws + WS_D);
    const float* cw = C.ka->in[21] + (size_t)l * 3 * FF2; const float* cb = C.ka->in[22] + (size_t)l * FF2;
    const int gt = C.blk * NTHREADS + C.tid, NGT = C.G * NTHREADS;
    for (int idx = gt; idx < 64 * FFH; idx += NGT) {
        const int pm = idx / FFH, jh = idx - pm * FFH;
        if ((pm & 15) == 0) continue;
        const int pn = jh >> 7, col = jh & 127;
        float o0[2], o1[2];
#pragma unroll
        for (int hf = 0; hf < 2; ++hf) {
            const int tc = pn * 256 + hf * 128 + col, wcn = hf * FFH + jh;
            const float hm2 = tail[(size_t)((pm - 1) * 2 + 0) * FF2 + tc], hm1 = tail[(size_t)((pm - 1) * 2 + 1) * FF2 + tc];
            const float h0 = head[(size_t)(pm * 2 + 0) * FF2 + tc], h1 = head[(size_t)(pm * 2 + 1) * FF2 + tc];
            const float w0 = cw[wcn], w1 = cw[FF2 + wcn], w2 = cw[2 * FF2 + wcn], bb = cb[wcn];
            o0[hf] = bb + w0 * hm2 + w1 * hm1 + w2 * h0; o1[hf] = bb + w0 * hm1 + w1 * h0 + w2 * h1;
        }
        ACT[(size_t)(pm * 256 + 0) * FFH + jh] = f2bf(siluf_(o0[0]) * o0[1]);
        ACT[(size_t)(pm * 256 + 1) * FFH + jh] = f2bf(siluf_(o1[0]) * o1[1]);
    }
}

namespace attn_body {
using bf16=unsigned short;
using bf16x8=__attribute__((ext_vector_type(8)))short;
using s16x4=__attribute__((ext_vector_type(4)))short;
using f32x16=__attribute__((ext_vector_type(16)))float;
using u32x4=__attribute__((ext_vector_type(4)))unsigned;
constexpr int BATCH=4,NHEAD=8,SEQ=4096,D=64,PQ=3584,PO=1536;
constexpr int NW=8,QBLK=32,QB=QBLK*NW,KVBLK=64,NQB=SEQ/QB;
constexpr int ATTN_UNIT_ROWS=QB;
__device__ __forceinline__ int crow(int r,int hi){return (r&3)+8*(r>>2)+4*hi;}
#define SBAR() __builtin_amdgcn_sched_barrier(0)
__device__ __forceinline__ void cmask(f32x16&p0,f32x16&p1,int jb,int qrel,int hi){
  const float NEG=-INFINITY; int kb=64*jb+4*hi;
  #pragma unroll
  for(int r=0;r<16;++r){int kv=kb+(r&3)+8*(r>>2); if(kv>qrel)p0[r]=NEG; if(kv+32>qrel)p1[r]=NEG;}
}

constexpr int NSLOT=3, SLOTB=8192;
constexpr int LDS_K=0, LDS_V=NSLOT*SLOTB, LDS_WS=2*NSLOT*SLOTB, LDS_OST=LDS_WS+NW*64*4, LDS_BYTES=LDS_OST+NW*4096;
constexpr float C2=0.125f*1.4426950408889634f;
__device__ __forceinline__ void glds16(const void*gsrc,unsigned lds_dst){unsigned keep;
  asm volatile("s_mov_b32 %0, m0\n\ts_mov_b32 m0, %2\n\ts_nop 0\n\tglobal_load_lds_dwordx4 %1, off\n\ts_mov_b32 m0, %0":"=&s"(keep):"v"(gsrc),"s"(lds_dst):"memory");}
__device__ __forceinline__ float max3f(float a,float b,float c){float r;asm("v_max3_f32 %0, %1, %2, %3":"=v"(r):"v"(a),"v"(b),"v"(c));return r;}
__device__ __forceinline__ float max2f(float a,float b){float r;asm("v_max_f32_e32 %0, %1, %2":"=v"(r):"v"(a),"v"(b));return r;}
__device__ __forceinline__ float fadd_s(float a,float b){float r;asm("v_add_f32_e32 %0, %1, %2":"=v"(r):"v"(a),"v"(b));return r;}
__device__ __forceinline__ float fsub_s(float a,float b){float r;asm("v_sub_f32_e32 %0, %1, %2":"=v"(r):"v"(a),"v"(b));return r;}
typedef float f32x2_t __attribute__((ext_vector_type(2))); typedef __bf16 bf16x2_t __attribute__((ext_vector_type(2)));
__device__ __forceinline__ unsigned cvtpk_s(float lo,float hi){f32x2_t v={lo,hi};bf16x2_t b=__builtin_convertvector(v,bf16x2_t);return __builtin_bit_cast(unsigned,b);}
#define WAIT_BAR(N) asm volatile("s_waitcnt vmcnt(" #N ") lgkmcnt(0)\n\ts_barrier":::"memory")

__device__ __forceinline__ void qkt(f32x16&p0,f32x16&p1,const char*Kslot,const bf16x8*qr,const f32x16&negm,int r32,int hi){
  const char*kb=Kslot+hi*1024+r32*16;
  #pragma unroll
  for(int d0=0;d0<4;++d0){
    const bf16x8 b0=*reinterpret_cast<const bf16x8*>(kb+d0*2048);
    const bf16x8 b1=*reinterpret_cast<const bf16x8*>(kb+d0*2048+512);
    if(d0==0){p0=__builtin_amdgcn_mfma_f32_32x32x16_bf16(b0,qr[0],negm,0,0,0);p1=__builtin_amdgcn_mfma_f32_32x32x16_bf16(b1,qr[0],negm,0,0,0);}
    else{p0=__builtin_amdgcn_mfma_f32_32x32x16_bf16(b0,qr[d0],p0,0,0,0);p1=__builtin_amdgcn_mfma_f32_32x32x16_bf16(b1,qr[d0],p1,0,0,0);}}
}
typedef __attribute__((address_space(3))) const char* lds_cptr;
typedef short v4i16_t __attribute__((ext_vector_type(4)));
__device__ __forceinline__ void kload8(bf16x8*kf,lds_cptr kp){
  kf[0]=*(const __attribute__((address_space(3))) bf16x8*)(kp);      kf[1]=*(const __attribute__((address_space(3))) bf16x8*)(kp+512);
  kf[2]=*(const __attribute__((address_space(3))) bf16x8*)(kp+2048); kf[3]=*(const __attribute__((address_space(3))) bf16x8*)(kp+2560);
  kf[4]=*(const __attribute__((address_space(3))) bf16x8*)(kp+4096); kf[5]=*(const __attribute__((address_space(3))) bf16x8*)(kp+4608);
  kf[6]=*(const __attribute__((address_space(3))) bf16x8*)(kp+6144); kf[7]=*(const __attribute__((address_space(3))) bf16x8*)(kp+6656);
}
__device__ __forceinline__ void kload2(bf16x8*kf,lds_cptr kp,int j){ kf[2*j]=*(const __attribute__((address_space(3))) bf16x8*)(kp+j*2048); kf[2*j+1]=*(const __attribute__((address_space(3))) bf16x8*)(kp+j*2048+512); }
__device__ __forceinline__ s16x4 vtr(lds_cptr p){ return __builtin_bit_cast(s16x4,__builtin_amdgcn_ds_read_tr16_b64_v4i16((__attribute__((address_space(3))) v4i16_t*)p)); }
__device__ __forceinline__ float rowmax(const f32x16&p0,const f32x16&p1){
  float a=max3f(p0[0],p0[1],p1[0]),b=max3f(p0[2],p0[3],p1[1]);a=max3f(a,p1[2],p1[3]);
  #pragma unroll
  for(int r=4;r<16;r+=4){a=max3f(a,p0[r],p0[r+1]);b=max3f(b,p0[r+2],p0[r+3]);a=max3f(a,p1[r],p1[r+1]);b=max3f(b,p1[r+2],p1[r+3]);}
  const float m=max2f(a,b);
  auto rr=__builtin_amdgcn_permlane32_swap(__float_as_uint(m),__float_as_uint(m),false,false);
  return max2f(__uint_as_float(rr[0]),__uint_as_float(rr[1]));
}
__device__ __forceinline__ void pv(f32x16*o,int vb,bf16x8 pa0,bf16x8 pa1,bf16x8 pa2,bf16x8 pa3){
  #pragma unroll
  for(int d0=0;d0<2;++d0){s16x4 lo[4],hi[4];
    #pragma unroll
    for(int ks=0;ks<4;++ks){
      asm volatile("ds_read_b64_tr_b16 %0,%1 offset:%c2":"=&v"(lo[ks]):"v"(vb),"i"(d0*4096+ks*1024):"memory");
      asm volatile("ds_read_b64_tr_b16 %0,%1 offset:%c2":"=&v"(hi[ks]):"v"(vb),"i"(d0*4096+ks*1024+512):"memory");}
    asm volatile("s_waitcnt lgkmcnt(0)":::"memory");SBAR();
    #define PK(k) (bf16x8){lo[k][0],lo[k][1],lo[k][2],lo[k][3],hi[k][0],hi[k][1],hi[k][2],hi[k][3]}
    o[d0]=__builtin_amdgcn_mfma_f32_32x32x16_bf16(pa0,PK(0),o[d0],0,0,0);
    o[d0]=__builtin_amdgcn_mfma_f32_32x32x16_bf16(pa1,PK(1),o[d0],0,0,0);
    o[d0]=__builtin_amdgcn_mfma_f32_32x32x16_bf16(pa2,PK(2),o[d0],0,0,0);
    o[d0]=__builtin_amdgcn_mfma_f32_32x32x16_bf16(pa3,PK(3),o[d0],0,0,0);
    #undef PK
  }
}

#ifndef ATTN_STORE16
#define ATTN_STORE16(p,v) (*(u32x4*)(p)=(v))
#endif
template<int THRL> __device__ __forceinline__ void attn_unit(int tid,int b,int h,int qb,const bf16*Q,const bf16* K,const bf16* V,bf16*O,const unsigned short*SEL,char*shm,int dry){
  const int lane=tid&63,r32=lane&31,hi=lane>>5; const int wid=__builtin_amdgcn_readfirstlane(tid>>6);
  const long rowbase=(long)b*SEQ; const int q0=qb*QB;
  const bf16*Qw=Q+(rowbase+q0+wid*QBLK)*PQ+h*D;
  const bf16*Kh=K+rowbase*PQ+h*D,*Vh=V+rowbase*PQ+h*D;
  const unsigned lds0=(unsigned)(uintptr_t)shm;
  float*wsf=(float*)(shm+LDS_WS)+wid*64;
  const bf16*ksrc=Kh+(long)lane*PQ+wid*8;
  const bf16*vsrc=Vh+(long)(16*(wid&3)+(lane>>2))*PQ+(wid>>2)*32+(lane&3)*8;
  const unsigned kdst=lds0+LDS_K+wid*1024, vdst=lds0+LDS_V+wid*1024;
  #define DMA_K(t,slot) glds16(ksrc+(long)(t)*KVBLK*PQ,(unsigned)__builtin_amdgcn_readfirstlane(kdst+(slot)))
  #define DMA_V(t,slot) glds16(vsrc+(long)(t)*KVBLK*PQ,(unsigned)__builtin_amdgcn_readfirstlane(vdst+(slot)))
  const int vb0=(int)(lds0+LDS_V)+((lane>>4)&1)*32+(lane&3)*8+(4*hi+((lane&15)>>2))*64;
  const char*Kbase=shm+LDS_K; bf16x8 kf[8];
  const lds_cptr shm3=(lds_cptr)shm; const lds_cptr kp0=shm3+LDS_K+hi*1024+r32*16; const lds_cptr vp0=shm3+LDS_V+((lane>>4)&1)*32+(lane&3)*8+(4*hi+((lane&15)>>2))*64;
  const int NT=(dry&2)?4:(q0+QB)/KVBLK;
  DMA_K(0,0);DMA_V(0,0);DMA_K(1,SLOTB);
  bf16x8 qr[4];
  #pragma unroll
  for(int d0=0;d0<4;++d0)qr[d0]=*reinterpret_cast<const bf16x8*>(&Qw[(long)r32*PQ+d0*16+hi*8]);
  #define QRD(k) qr[k]
  float l_reg=0.f;f32x16 o[2];o[0]=f32x16{};o[1]=f32x16{};const f32x16 negm=f32x16{};
  const int qrel=wid*QBLK+r32;
  const unsigned selm=SEL[((long)(b*NHEAD+h))*SEQ+q0+qrel];
  #define SELM(P0,P1,t) do{ if(!(dry&4)&&!((selm>>((t)>>2))&1u)){ _Pragma("unroll") for(int r=0;r<16;++r){P0[r]=-INFINITY;P1[r]=-INFINITY;} } }while(0)
  #define CMASK(P0,P1,t) do{int jb_=(t)-(NT-4); if(jb_>=0)cmask(P0,P1,jb_,qrel,hi);}while(0)
  bool resc=false;
  #define START(P0,P1) do{ resc=false; \
    _Pragma("unroll") for(int r=0;r<16;++r)P0[r]=__builtin_amdgcn_exp2f(P0[r]); }while(0)
  #define RESC() do{ if(resc){ asm volatile("s_waitcnt lgkmcnt(0)":::"memory"); \
      _Pragma("unroll") for(int d_=0;d_<2;++d_) _Pragma("unroll") for(int r=0;r<16;++r)o[d_][r]*=wsf[crow(r,hi)]; } }while(0)
  f32x16 pA0,pA1,pB0,pB1;
  int sl_prev=0,sl_cur=0,sl_next=SLOTB;
  #define ROT() do{sl_prev=sl_cur;sl_cur=sl_next;sl_next=(sl_next==(NSLOT-1)*SLOTB)?0:sl_next+SLOTB;}while(0)
  DMA_K(2,2*SLOTB);
  WAIT_BAR(3);
  qkt(pA0,pA1,Kbase,qr,negm,r32,hi);asm volatile("s_nop 15\n\ts_nop 7":"+v"(pA0),"+v"(pA1));CMASK(pA0,pA1,0);SELM(pA0,pA1,0);
  START(pA0,pA1);
  _Pragma("unroll") for(int r=0;r<16;++r)pA1[r]=__builtin_amdgcn_exp2f(pA1[r]);
  WAIT_BAR(0);
  DMA_K(3,0);DMA_V(1,SLOTB);
  ROT();
  kload8(kf,kp0+sl_cur);
  WAIT_BAR(2);
  s16x4 vlo[8],vhi[8]; u32x4 pw0,pw1,pw2,pw3;
  #define PKW(P,B) cvtpk_s(P[B],P[B+1])
  #define PAF(k) __builtin_bit_cast(bf16x8,pw##k)
  #define VFR(i) (bf16x8){vlo[i][0],vlo[i][1],vlo[i][2],vlo[i][3],vhi[i][0],vhi[i][1],vhi[i][2],vhi[i][3]}
  #define PIN(x) asm volatile("":"+v"(x))
  #define MX3(a,b,c) __builtin_fmaxf(__builtin_fmaxf((a),(b)),(c))
  #define GAPA(MF,A0,A1,A2,A3,W0,W1,PW) do{ MF; sacc+=A0; sacc+=A1; sacc+=A2; sacc+=A3; PIN(sacc); W0; W1; PIN(PW); SBAR(); }while(0)
  #define EX(v) __builtin_amdgcn_exp2f(v)
  #define GAPB(MF,X,B) do{ MF; X[B]=EX(X[B]); X[B+1]=EX(X[B+1]); X[B+2]=EX(X[B+2]); X[B+3]=EX(X[B+3]); PIN(X); SBAR(); }while(0)
  #define VRD(i) do{ vlo[i]=vtr(vp_+(((i)>>2)*4096+((i)&3)*1024)); vhi[i]=vtr(vp_+(((i)>>2)*4096+((i)&3)*1024+512)); }while(0)
  #define KRD(G,j) do{ if(G){ kload2(kf,kp0+sl_next,j); SBAR(); } }while(0)
  #define STEP(C0,C1,P0,P1,t,GK,GV,GL) do{ SBAR(); \
    const lds_cptr vp_=vp0+sl_prev; \
    VRD(0); SBAR(); float sacc=(P0[0]+P0[1]); \
    GAPA(C0=__builtin_amdgcn_mfma_f32_32x32x16_bf16(kf[0],QRD(0),negm,0,0,0), P0[2],P0[3],P0[4],P0[5],     pw0[0]=PKW(P0,0), pw0[1]=PKW(P0,2), pw0); \
    VRD(4); SBAR(); GAPA(C1=__builtin_amdgcn_mfma_f32_32x32x16_bf16(kf[1],QRD(0),negm,0,0,0), P0[6],P0[7],P0[8],P0[9],     pw0[2]=PKW(P0,4), pw0[3]=PKW(P0,6), pw0); \
    VRD(1); SBAR(); GAPA(C0=__builtin_amdgcn_mfma_f32_32x32x16_bf16(kf[2],QRD(1),C0,0,0,0),   P0[10],P0[11],P0[12],P0[13], pw1[0]=PKW(P0,8), pw1[1]=PKW(P0,10), pw1); \
    VRD(5); SBAR(); GAPA(C1=__builtin_amdgcn_mfma_f32_32x32x16_bf16(kf[3],QRD(1),C1,0,0,0),   P0[14],P0[15],P1[0],P1[1],   pw1[2]=PKW(P0,12),pw1[3]=PKW(P0,14), pw1); \
    VRD(2); SBAR(); GAPA(C0=__builtin_amdgcn_mfma_f32_32x32x16_bf16(kf[4],QRD(2),C0,0,0,0),   P1[2],P1[3],P1[4],P1[5],     pw2[0]=PKW(P1,0), pw2[1]=PKW(P1,2), pw2); \
    VRD(6); SBAR(); GAPA(C1=__builtin_amdgcn_mfma_f32_32x32x16_bf16(kf[5],QRD(2),C1,0,0,0),   P1[6],P1[7],P1[8],P1[9],     pw2[2]=PKW(P1,4), pw2[3]=PKW(P1,6), pw2); \
    VRD(3); SBAR(); GAPA(C0=__builtin_amdgcn_mfma_f32_32x32x16_bf16(kf[6],QRD(3),C0,0,0,0),   P1[10],P1[11],P1[12],P1[13], pw3[0]=PKW(P1,8), pw3[1]=PKW(P1,10), pw3); \
    VRD(7); SBAR(); GAPA(C1=__builtin_amdgcn_mfma_f32_32x32x16_bf16(kf[7],QRD(3),C1,0,0,0),   P1[14],P1[15],0.f,0.f,       pw3[2]=PKW(P1,12),pw3[3]=PKW(P1,14), pw3); \
    l_reg+=sacc; \
    if(GK){DMA_K((t)+3,sl_cur);} if(GV){DMA_V((t)+1,sl_next);} \
    CMASK(C0,C1,t); SELM(C0,C1,t); \
      \
    SBAR(); \
    GAPB(o[0]=__builtin_amdgcn_mfma_f32_32x32x16_bf16(PAF(0),VFR(0),o[0],0,0,0), C0,0); \
    GAPB(o[1]=__builtin_amdgcn_mfma_f32_32x32x16_bf16(PAF(0),VFR(4),o[1],0,0,0), C0,4); \
    KRD(GL,0); GAPB(o[0]=__builtin_amdgcn_mfma_f32_32x32x16_bf16(PAF(1),VFR(1),o[0],0,0,0), C0,8); \
    KRD(GL,1); GAPB(o[1]=__builtin_amdgcn_mfma_f32_32x32x16_bf16(PAF(1),VFR(5),o[1],0,0,0), C0,12); \
    KRD(GL,2); GAPB(o[0]=__builtin_amdgcn_mfma_f32_32x32x16_bf16(PAF(2),VFR(2),o[0],0,0,0), C1,0); \
    KRD(GL,3); GAPB(o[1]=__builtin_amdgcn_mfma_f32_32x32x16_bf16(PAF(2),VFR(6),o[1],0,0,0), C1,4); \
    GAPB(o[0]=__builtin_amdgcn_mfma_f32_32x32x16_bf16(PAF(3),VFR(3),o[0],0,0,0), C1,8); \
    GAPB(o[1]=__builtin_amdgcn_mfma_f32_32x32x16_bf16(PAF(3),VFR(7),o[1],0,0,0), C1,12); \
    }while(0)
  int t=1;
  #undef CMASK
  #define CMASK(P0,P1,t) do{}while(0)
  for(;t+5<NT;t+=2){
    STEP(pB0,pB1,pA0,pA1,t,true,true,true);     WAIT_BAR(2); RESC(); ROT();
    STEP(pA0,pA1,pB0,pB1,t+1,true,true,true);   WAIT_BAR(2); RESC(); ROT();
  }
  #undef CMASK
  #define CMASK(P0,P1,t) do{int jb_=(t)-(NT-4); if(jb_>=0)cmask(P0,P1,jb_,qrel,hi);}while(0)
  #define ENDW(tt) do{ if((tt)+3<NT){WAIT_BAR(2);} else if((tt)+2<NT){WAIT_BAR(1);} else {WAIT_BAR(0);} }while(0)
  for(;t+1<NT;t+=2){
    STEP(pB0,pB1,pA0,pA1,t,(t+3<NT),(t+1<NT),(t+1<NT));       ENDW(t);   RESC(); ROT();
    STEP(pA0,pA1,pB0,pB1,t+1,(t+4<NT),(t+2<NT),(t+2<NT));     ENDW(t+1); RESC(); ROT();
  }
  STEP(pB0,pB1,pA0,pA1,NT-1,false,false,false); RESC();
  { float sacc=pB0[0]+pB0[1]; _Pragma("unroll") for(int r=2;r<16;++r)sacc+=pB0[r]; _Pragma("unroll") for(int r=0;r<16;++r)sacc+=pB1[r]; l_reg+=sacc;
    pw0=(u32x4){PKW(pB0,0),PKW(pB0,2),PKW(pB0,4),PKW(pB0,6)};pw1=(u32x4){PKW(pB0,8),PKW(pB0,10),PKW(pB0,12),PKW(pB0,14)};pw2=(u32x4){PKW(pB1,0),PKW(pB1,2),PKW(pB1,4),PKW(pB1,6)};pw3=(u32x4){PKW(pB1,8),PKW(pB1,10),PKW(pB1,12),PKW(pB1,14)};
    SBAR(); pv(o,vb0+sl_cur,PAF(0),PAF(1),PAF(2),PAF(3)); }
  #undef PKW
  #undef PAF
  #undef VFR
  #undef PIN
  #undef MX3
  #undef GAPA
  #undef GAPB
  #undef EX
  #undef VRD
  #undef KRD
  #undef STEP
  #undef ENDW
  {auto rr=__builtin_amdgcn_permlane32_swap(__float_as_uint(l_reg),__float_as_uint(l_reg),false,false);l_reg=__uint_as_float(rr[0])+__uint_as_float(rr[1]);}
  if(hi==0)wsf[32+r32]=l_reg;asm volatile("s_waitcnt lgkmcnt(0)":::"memory");
  float rli[16];
  #pragma unroll
  for(int r=0;r<16;++r)rli[r]=__builtin_amdgcn_rcpf(wsf[32+crow(r,hi)]);
  bf16*Ow=O+(rowbase+q0+wid*QBLK)*PO+h*D;
  { bf16*stg=(bf16*)(shm+LDS_OST)+wid*2048;
    #pragma unroll
    for(int r=0;r<16;++r){const int orow=crow(r,hi);
      #pragma unroll
      for(int d0=0;d0<2;++d0)stg[orow*64+d0*32+r32]=f2bf(o[d0][r]*rli[r]);}
    asm volatile("s_waitcnt lgkmcnt(0)":::"memory");
    #pragma unroll
    for(int i=0;i<4;++i){const int row=i*8+(lane>>3),ch=lane&7; const u32x4 v=*(const u32x4*)(stg+row*64+ch*8); if(!dry)ATTN_STORE16(Ow+(long)row*PO+ch*8,v);} }
  asm volatile("s_waitcnt lgkmcnt(0)\n\ts_barrier":::"memory");
  #undef QRD
  #undef SELM
  #undef DMA_K
  #undef DMA_V
  #undef CMASK
  #undef START
  #undef RESC
  #undef ROT
}
constexpr int ATTN_LDS_BYTES=LDS_BYTES;
struct AttnTensors { const bf16* Q; const bf16* K; const bf16* V; bf16* O; const unsigned short* SEL; int dry; };
struct AttnUnit { int bh; int qb; };
struct StaticOrder {
  int vcu;
  __device__ __forceinline__ explicit StaticOrder(int grid,int block):vcu((grid%8==0)?(block%8)*(grid/8)+block/8:block),G(grid){}
  int G;
  __device__ __forceinline__ bool next(int i,AttnUnit&u)const{ const int v=vcu+(i>>1)*G; if(v>=256)return false; const int s=v&7; u.bh=v>>3; u.qb=(i&1)?s:15-s; return true; }
};
template<class Sched,int THRL=8> __device__ __forceinline__ void attn_phase(int tid,char*lds,const AttnTensors&T,const Sched&S){
  AttnUnit u;
  for(int i=0;S.next(i,u);++i){ attn_unit<THRL>(tid,u.bh/NHEAD,u.bh%NHEAD,u.qb,T.Q,T.K,T.V,T.O,T.SEL,lds,T.dry); }
}
#undef SBAR
#undef WAIT_BAR
}

constexpr size_t WS_SEL = 640 * 1024;
__device__ __forceinline__ void select_unit(const Ctx& C, int u) {
    const bf16_t* P = (const bf16_t*)(C.ws + WS_D); const float* KM = (const float*)(C.ws + WS_KMEAN); unsigned short* SEL = (unsigned short*)(C.ws + WS_SEL);
    const int lane = (C.tid & 63), w = __builtin_amdgcn_readfirstlane(C.tid >> 6), g = lane >> 4, i = lane & 15;
    LAS unsigned char* sc = C.lds + w * 5120;
    const int bh = u >> 3, ch = u & 7, b = bh >> 3, h = bh & 7;
    const int t0 = ch * 512 + 64 * w, qblk = t0 >> 8;
    bf16x8 ah[2], al[2];
#pragma unroll
    for (int ks = 0; ks < 2; ++ks) {
        const float* kp = KM + bh * 1024 + i * 64 + 32 * ks + 8 * g;
        const f32x4 x0 = *(const f32x4*)kp, x1 = *(const f32x4*)(kp + 4);
        u32x4 ph, pl;
        ph.x = cvt_pk_bf16(x0.x, x0.y); pl.x = cvt_pk_bf16(x0.x - bflo(ph.x), x0.y - bfhi(ph.x));
        ph.y = cvt_pk_bf16(x0.z, x0.w); pl.y = cvt_pk_bf16(x0.z - bflo(ph.y), x0.w - bfhi(ph.y));
        ph.z = cvt_pk_bf16(x1.x, x1.y); pl.z = cvt_pk_bf16(x1.x - bflo(ph.z), x1.y - bfhi(ph.z));
        ph.w = cvt_pk_bf16(x1.z, x1.w); pl.w = cvt_pk_bf16(x1.z - bflo(ph.w), x1.w - bfhi(ph.w));
        ah[ks] = (bf16x8)ph; al[ks] = (bf16x8)pl;
    }
#pragma unroll
    for (int tt = 0; tt < 4; ++tt) {
        const bf16_t* qp = P + (size_t)(b * SEQ + t0 + 16 * tt + i) * NNG + C_QA + h * 64 + 8 * g;
        const bf16x8 q0 = *(const bf16x8*)qp, q1 = *(const bf16x8*)(qp + 32);
        f32x4 acc = (f32x4){0.f, 0.f, 0.f, 0.f};
        acc = __builtin_amdgcn_mfma_f32_16x16x32_bf16(ah[0], q0, acc, 0, 0, 0);
        acc = __builtin_amdgcn_mfma_f32_16x16x32_bf16(al[0], q0, acc, 0, 0, 0);
        acc = __builtin_amdgcn_mfma_f32_16x16x32_bf16(ah[1], q1, acc, 0, 0, 0);
        acc = __builtin_amdgcn_mfma_f32_16x16x32_bf16(al[1], q1, acc, 0, 0, 0);
        *(LAS f32x4*)(sc + (16 * tt + i) * 80 + g * 16) = acc;
    }
    asm volatile("s_waitcnt lgkmcnt(0)" ::: "memory");
    const f32x4 s0 = *(const LAS f32x4*)(sc + lane * 80), s1 = *(const LAS f32x4*)(sc + lane * 80 + 16), s2 = *(const LAS f32x4*)(sc + lane * 80 + 32), s3 = *(const LAS f32x4*)(sc + lane * 80 + 48);
    float v1 = -INFINITY, v2 = -INFINITY, v3 = -INFINITY; int i1 = -1, i2 = -1, i3 = -1;
#define SEL_INS(G_, J_) if ((J_) < qblk) { const float gq = (G_); \
        if (gq > v1) { v3 = v2; i3 = i2; v2 = v1; i2 = i1; v1 = gq; i1 = (J_); } \
        else if (gq > v2) { v3 = v2; i3 = i2; v2 = gq; i2 = (J_); } \
        else if (gq > v3) { v3 = gq; i3 = (J_); } }
    SEL_INS(s0.x, 0) SEL_INS(s0.y, 1) SEL_INS(s0.z, 2) SEL_INS(s0.w, 3)
    SEL_INS(s1.x, 4) SEL_INS(s1.y, 5) SEL_INS(s1.z, 6) SEL_INS(s1.w, 7)
    SEL_INS(s2.x, 8) SEL_INS(s2.y, 9) SEL_INS(s2.z, 10) SEL_INS(s2.w, 11)
    SEL_INS(s3.x, 12) SEL_INS(s3.y, 13) SEL_INS(s3.z, 14)
#undef SEL_INS
    unsigned m = 1u << qblk;
    if (i1 >= 0) m |= 1u << i1;
    if (i2 >= 0) m |= 1u << i2;
    if (i3 >= 0) m |= 1u << i3;
    SEL[(size_t)bh * SEQ + t0 + lane] = (unsigned short)m;
}
__device__ __forceinline__ void phase_select(const Ctx& C) {
    for (int u = C.blk; u < 256; u += C.G) select_unit(C, u);
}


constexpr size_t WS_KVS = WS_G + 17 * MiB;
typedef short v4i16_t __attribute__((ext_vector_type(4)));
__device__ __forceinline__ v4i16_t lds_tr16(LAS unsigned char* p) { return __builtin_amdgcn_ds_read_tr16_b64_v4i16((LAS v4i16_t*)p); }
__device__ __forceinline__ bf16x8 cat44(v4i16_t a, v4i16_t b) { return (bf16x8){a[0], a[1], a[2], a[3], b[0], b[1], b[2], b[3]}; }

__device__ __forceinline__ void ret_kv_unit(const Ctx& C, int bh, int n) {
    const int tid = C.tid, lane = (C.tid & 63), w = __builtin_amdgcn_readfirstlane(C.tid >> 6), g = lane >> 4, i = lane & 15;
    const int b = bh >> 2, h = bh & 3;
    const bf16_t* P = (const bf16_t*)(C.ws + WS_D) + (size_t)(b * SEQ + n * 128) * NNG;
    LAS unsigned char* Kimg = C.lds; LAS unsigned char* Vimg = C.lds + 16384;
    const float lg2 = log2f(1.f - exp2f(-5.f - (float)h));
    __syncthreads();
#pragma unroll
    for (int r = 0; r < 2; ++r) { const int id = tid + 512 * r, m = id >> 3, ch = id & 7;
        *(LAS u32x4*)(Kimg + m * 128 + ch * 16) = *(const u32x4*)(P + (size_t)m * NNG + C_KR + h * 64 + 8 * ch); }
#pragma unroll
    for (int r = 0; r < 4; ++r) { const int id = tid + 512 * r, m = id >> 4, ch = id & 15;
        const u32x4 v = *(const u32x4*)(P + (size_t)m * NNG + C_VR + h * 128 + 8 * ch);
        const float z = exp2f(lg2 * (float)(127 - m));
        u32x4 o; o.x = cvt_pk_bf16(bflo(v.x) * z, bfhi(v.x) * z); o.y = cvt_pk_bf16(bflo(v.y) * z, bfhi(v.y) * z); o.z = cvt_pk_bf16(bflo(v.z) * z, bfhi(v.z) * z); o.w = cvt_pk_bf16(bflo(v.w) * z, bfhi(v.w) * z);
        *(LAS u32x4*)(Vimg + m * 256 + ch * 16) = o; }
    __syncthreads();
    f32x4 acc[4];
#pragma unroll
    for (int dt = 0; dt < 4; ++dt) acc[dt] = (f32x4){0.f, 0.f, 0.f, 0.f};
    const int e0 = 16 * w;
#pragma unroll
    for (int ks = 0; ks < 4; ++ks) {
        const int mr = 32 * ks + 8 * g + (i >> 2);
        const bf16x8 A = cat44(lds_tr16(Vimg + mr * 256 + (e0 + 4 * (i & 3)) * 2), lds_tr16(Vimg + (mr + 4) * 256 + (e0 + 4 * (i & 3)) * 2));
#pragma unroll
        for (int dt = 0; dt < 4; ++dt) {
            const bf16x8 B = cat44(lds_tr16(Kimg + mr * 128 + (16 * dt + 4 * (i & 3)) * 2), lds_tr16(Kimg + (mr + 4) * 128 + (16 * dt + 4 * (i & 3)) * 2));
            acc[dt] = __builtin_amdgcn_mfma_f32_16x16x32_bf16(A, B, acc[dt], 0, 0, 0);
        }
    }
    bf16_t* KV = (bf16_t*)(C.ws + WS_KVS) + (size_t)(bh * 32 + n) * 8192;
#pragma unroll
    for (int dt = 0; dt < 4; ++dt)
#pragma unroll
        for (int r = 0; r < 4; ++r) KV[(e0 + 4 * g + r) * 64 + 16 * dt + i] = f2bf(acc[dt][r]);
}
__device__ __forceinline__ void ret_scan(const Ctx& C) {
    const int gt = C.blk * NTHREADS + C.tid, NGT = C.G * NTHREADS;
    for (int idx = gt; idx < 16 * 8192; idx += NGT) {
        const int bh = idx >> 13, el = idx & 8191, h = bh & 3;
        const float cd = exp2f(128.f * log2f(1.f - exp2f(-5.f - (float)h)));
        bf16_t* p = (bf16_t*)(C.ws + WS_KVS) + (size_t)bh * 32 * 8192 + el;
        float v[32];
#pragma unroll
        for (int n = 0; n < 32; ++n) v[n] = bf2f(p[(size_t)n * 8192]);
        float st = 0.f;
#pragma unroll
        for (int n = 0; n < 32; ++n) { p[(size_t)n * 8192] = f2bf(st); st = cd * st + v[n]; }
    }
}
__device__ __forceinline__ void ret_out_unit(const Ctx& C, int l, int bh, int n) {
    const int tid = C.tid, lane = (C.tid & 63), w = __builtin_amdgcn_readfirstlane(C.tid >> 6), g = lane >> 4, i = lane & 15;
    const int b = bh >> 2, h = bh & 3;
    const size_t row0 = (size_t)(b * SEQ + n * 128);
    const bf16_t* P = (const bf16_t*)(C.ws + WS_D) + row0 * NNG;
    LAS unsigned char* Vimg = C.lds; LAS unsigned char* Kimg = C.lds + 32768; LAS unsigned char* Simg = C.lds + 49152;
    const float lg2 = log2f(1.f - exp2f(-5.f - (float)h));
    const bf16_t* ST = (const bf16_t*)(C.ws + WS_KVS) + (size_t)(bh * 32 + n) * 8192;
    const int c = 16 * w + i;
    __syncthreads();
    {
        u32x4 vv[4], kk[2], ss[2];
#pragma unroll
        for (int r = 0; r < 4; ++r) { const int id = tid + 512 * r; vv[r] = *(const u32x4*)(P + (size_t)(id >> 4) * NNG + C_VR + h * 128 + 8 * (id & 15)); }
#pragma unroll
        for (int r = 0; r < 2; ++r) { const int id = tid + 512 * r; kk[r] = *(const u32x4*)(P + (size_t)(id >> 3) * NNG + C_KR + h * 64 + 8 * (id & 7)); ss[r] = *(const u32x4*)(ST + (size_t)id * 8); }
#pragma unroll
        for (int r = 0; r < 4; ++r) { const int id = tid + 512 * r; *(LAS u32x4*)(Vimg + (id >> 4) * 256 + (id & 15) * 16) = vv[r]; }
#pragma unroll
        for (int r = 0; r < 2; ++r) { const int id = tid + 512 * r; *(LAS u32x4*)(Kimg + id * 16) = kk[r]; *(LAS u32x4*)(Simg + id * 16) = ss[r]; }
    }
    bf16x8 qf[2];
#pragma unroll
    for (int ks = 0; ks < 2; ++ks) qf[ks] = *(const bf16x8*)(P + (size_t)c * NNG + C_QR + h * 64 + 32 * ks + 8 * g);
    const bf16_t* GS = P + (size_t)c * NNG + C_GR + h * 128;
    u32x2 gsv[8];
#pragma unroll
    for (int et = 0; et < 8; ++et) gsv[et] = *(const u32x2*)(GS + 16 * et + 4 * g);
    __syncthreads();
    f32x4 acc[8];
#pragma unroll
    for (int et = 0; et < 8; ++et) {
        acc[et] = (f32x4){0.f, 0.f, 0.f, 0.f};
#pragma unroll
        for (int ks = 0; ks < 2; ++ks) { const bf16x8 A = *(const LAS bf16x8*)(Simg + (16 * et + i) * 128 + (32 * ks + 8 * g) * 2);
            acc[et] = __builtin_amdgcn_mfma_f32_16x16x32_bf16(A, qf[ks], acc[et], 0, 0, 0); }
    }
    const float xi = __builtin_amdgcn_exp2f(lg2 * (float)(c + 1));
#pragma unroll
    for (int et = 0; et < 8; ++et) acc[et] *= xi;
#pragma unroll
    for (int s = 0; s < 4; ++s) {
        if (2 * s <= w) {
            f32x4 st[2];
#pragma unroll
            for (int u = 0; u < 2; ++u) {
                const int mt = 2 * s + u;
                st[u] = (f32x4){0.f, 0.f, 0.f, 0.f};
                if (mt <= w) {
#pragma unroll
                    for (int ks = 0; ks < 2; ++ks) { const bf16x8 Kf = *(const LAS bf16x8*)(Kimg + (16 * mt + i) * 128 + (32 * ks + 8 * g) * 2);
                        st[u] = __builtin_amdgcn_mfma_f32_16x16x32_bf16(Kf, qf[ks], st[u], 0, 0, 0); }
#pragma unroll
                    for (int r = 0; r < 4; ++r) { const int m = 16 * mt + 4 * g + r; st[u][r] = (c >= m) ? st[u][r] * __builtin_amdgcn_exp2f(lg2 * (float)(c - m)) : 0.f; }
                }
            }
            bf16x8 Pf;
            { u32x4 pw; pw.x = cvt_pk_bf16(st[0][0], st[0][1]); pw.y = cvt_pk_bf16(st[0][2], st[0][3]); pw.z = cvt_pk_bf16(st[1][0], st[1][1]); pw.w = cvt_pk_bf16(st[1][2], st[1][3]); Pf = __builtin_bit_cast(bf16x8, pw); }
            const int mr = 32 * s + 4 * g + (i >> 2);
#pragma unroll
            for (int et = 0; et < 8; ++et) {
                const bf16x8 A = cat44(lds_tr16(Vimg + mr * 256 + (16 * et + 4 * (i & 3)) * 2), lds_tr16(Vimg + (mr + 16) * 256 + (16 * et + 4 * (i & 3)) * 2));
                acc[et] = __builtin_amdgcn_mfma_f32_16x16x32_bf16(A, Pf, acc[et], 0, 0, 0);
            }
        }
    }
    float sm = 0.f;
#pragma unroll
    for (int et = 0; et < 8; ++et) sm += (acc[et][0] + acc[et][1]) + (acc[et][2] + acc[et][3]);
    sm += shx(sm, 16, lane); sm += shx(sm, 32, lane);
    const float mu = sm * (1.0f / 128.0f); float q2 = 0.f;
#pragma unroll
    for (int et = 0; et < 8; ++et) { acc[et] -= mu; q2 += (acc[et][0] * acc[et][0] + acc[et][1] * acc[et][1]) + (acc[et][2] * acc[et][2] + acc[et][3] * acc[et][3]); }
    q2 += shx(q2, 16, lane); q2 += shx(q2, 32, lane);
    const float rs = rsqrtf(q2 * (1.0f / 128.0f) + NORM_EPS);
    const float* gn = C.ka->in[12] + l * 512 + h * 128;
    bf16_t* Y = (bf16_t*)(C.ws + WS_E) + (row0 + c) * 1536 + 512 + h * 128;
#pragma unroll
    for (int et = 0; et < 8; ++et) {
        const int e = 16 * et + 4 * g;
        const u32x2 gs = gsv[et]; const f32x4 gg = *(const f32x4*)(gn + e);
        u32x2 o; o.x = cvt_pk_bf16(bflo(gs.x) * (acc[et][0] * rs * gg.x), bfhi(gs.x) * (acc[et][1] * rs * gg.y));
        o.y = cvt_pk_bf16(bflo(gs.y) * (acc[et][2] * rs * gg.z), bfhi(gs.y) * (acc[et][3] * rs * gg.w));
        *(u32x2*)(Y + e) = o;
    }
}


constexpr size_t WS_S5_BT2 = 212 * MiB;
constexpr size_t WS_S5_BT1 = 232 * MiB;
constexpr size_t WS_S5_SN = 237 * MiB;
constexpr size_t WS_S5_SP = 241 * MiB;
__device__ __forceinline__ void s5_gen_unit(const Ctx& C, int l, int g, int dp) {
    const int tid = C.tid;
    LAS float* wp = (LAS float*)C.lds;
    LAS float* wq = wp + 5 * 64 * 2;
    LAS float* bb = wq + 32 * 8 * 2;
    const float dt = expf(C.ka->in[5][l * 32 + g]);
    const float* LRE = C.ka->in[3] + (l * 32 + g) * 64; const float* LIM = C.ka->in[4] + (l * 32 + g) * 64;
    __syncthreads();
    if (tid < 320) { const int p = tid & 63; const float d = (float)(4 * dp + (tid >> 6));
        const float er = expf(d * LRE[p] * dt); float sn, cs; sincos_red(d * LIM[p] * dt, sn, cs);
        wp[tid * 2] = er * cs; wp[tid * 2 + 1] = er * sn; }
    if (tid < 256) { const int p = 8 * dp + (tid & 7); const float d = (float)(31 - (tid >> 3));
        const float er = expf(d * LRE[p] * dt); float sn, cs; sincos_red(d * LIM[p] * dt, sn, cs);
        wq[tid * 2] = er * cs; wq[tid * 2 + 1] = er * sn; }
    for (int idx = tid; idx < 1024; idx += NTHREADS) { const int p = idx >> 4;
        const float lre = LRE[p], lim = LIM[p];
        const float er = expf(lre * dt); float sn, cs; sincos_red(lim * dt, sn, cs);
        const float nr = er * cs - 1.f, ni = er * sn, den = lre * lre + lim * lim;
        const float cr = (nr * lre + ni * lim) / den, ci = (ni * lre - nr * lim) / den;
        const float br = C.ka->in[6][(size_t)(l * 32 + g) * 1024 + idx], bi = C.ka->in[7][(size_t)(l * 32 + g) * 1024 + idx];
        bb[idx * 2] = cr * br - ci * bi; bb[idx * 2 + 1] = cr * bi + ci * br; }
    __syncthreads();
    bf16_t* BT2 = (bf16_t*)(C.ws + WS_S5_BT2) + (size_t)g * 512 * 640;
    {
        const int lane = (tid & 63), w = __builtin_amdgcn_readfirstlane(tid >> 6), g4 = lane >> 4, i = lane & 15;
        const int dd = w & 3, th = w >> 2, d = 4 * dp + dd;
        const float* CR = C.ka->in[8] + (size_t)(l * 32 + g) * 1024 + i * 64; const float* CI = C.ka->in[9] + (size_t)(l * 32 + g) * 1024 + i * 64;
        f32x4 acc = (f32x4){0.f, 0.f, 0.f, 0.f};
#pragma unroll
        for (int ks = 0; ks < 4; ++ks) {
            const int p0 = 16 * ks + 4 * g4;
            const f32x4 cr4 = *(const f32x4*)(CR + p0), ci4 = *(const f32x4*)(CI + p0);
            u32x4 ah, al, bh, bl, sv;
#pragma unroll
            for (int j = 0; j < 4; ++j) {
                const int p = p0 + j; const float cr = cr4[j], ci = ci4[j];
                const float w0r = wp[(dd * 64 + p) * 2], w0i = wp[(dd * 64 + p) * 2 + 1], w1r = wp[((dd + 1) * 64 + p) * 2], w1i = wp[((dd + 1) * 64 + p) * 2 + 1];
                const float tr = cr * w0r - ci * w0i, ti = cr * w0i + ci * w0r;
                const float nr = cr * w1r - ci * w1i, ni = -(cr * w1i + ci * w1r);
                const float ar = bb[(p * 16 + i) * 2], ai = -bb[(p * 16 + i) * 2 + 1];
                const unsigned th_ = cvt_pk_bf16(tr, ti), ah_ = cvt_pk_bf16(ar, ai);
                bh[j] = th_; bl[j] = cvt_pk_bf16(tr - bflo(th_), ti - bfhi(th_));
                ah[j] = ah_; al[j] = cvt_pk_bf16(ar - bflo(ah_), ai - bfhi(ah_));
                sv[j] = cvt_pk_bf16(nr, ni);
            }
            acc = __builtin_amdgcn_mfma_f32_16x16x32_bf16((bf16x8)ah, (bf16x8)bh, acc, 0, 0, 0);
            acc = __builtin_amdgcn_mfma_f32_16x16x32_bf16((bf16x8)ah, (bf16x8)bl, acc, 0, 0, 0);
            acc = __builtin_amdgcn_mfma_f32_16x16x32_bf16((bf16x8)al, (bf16x8)bh, acc, 0, 0, 0);
            if ((ks & 1) == th) *(u32x4*)(BT2 + (size_t)(d * 16 + i) * 640 + 512 + 2 * p0) = sv;
        }
        u32x2 o; o.x = cvt_pk_bf16(acc[0], acc[1]); o.y = cvt_pk_bf16(acc[2], acc[3]);
        for (int sk = th; sk + d < 32; sk += 2) *(u32x2*)(BT2 + (size_t)((sk + d) * 16 + i) * 640 + sk * 16 + 4 * g4) = o;
    }
    for (int idx = tid; idx < 64 * 64; idx += NTHREADS) {
        const int rl = idx >> 6, ch = idx & 63, row = 64 * dp + rl, t = row >> 4;
        if ((ch >> 1) > t) *(u32x4*)(BT2 + (size_t)row * 640 + ch * 8) = (u32x4){0u, 0u, 0u, 0u};
    }
    bf16_t* BT1 = (bf16_t*)(C.ws + WS_S5_BT1) + (size_t)g * 128 * 512;
    for (int idx = tid; idx < 16 * 64; idx += NTHREADS) {
        const int rr = idx >> 6, row = 16 * dp + rr, ch = idx & 63, p = row >> 1, ri = row & 1, sk = ch >> 1, hf = ch & 1;
        const float wr_ = wq[(sk * 8 + (rr >> 1)) * 2], wi_ = wq[(sk * 8 + (rr >> 1)) * 2 + 1];
        float v[8];
#pragma unroll
        for (int j = 0; j < 8; ++j) { const float br = bb[(p * 16 + 8 * hf + j) * 2], bi = bb[(p * 16 + 8 * hf + j) * 2 + 1];
            v[j] = ri ? (wr_ * bi + wi_ * br) : (wr_ * br - wi_ * bi); }
        u32x4 o; o.x = cvt_pk_bf16(v[0], v[1]); o.y = cvt_pk_bf16(v[2], v[3]); o.z = cvt_pk_bf16(v[4], v[5]); o.w = cvt_pk_bf16(v[6], v[7]);
        *(u32x4*)(BT1 + (size_t)row * 512 + ch * 8) = o;
    }
    if (g == 31 && dp == 7) {
        for (int idx = tid; idx < 128 * 64; idx += NTHREADS) *(u32x4*)(BT1 + (size_t)128 * 512 + idx * 8) = (u32x4){0u, 0u, 0u, 0u};
    }
}
__device__ __forceinline__ void s5_scan_unit(const Ctx& C, int l, int b, int g) {
    const int p = (C.tid & 63);
    const float lre = C.ka->in[3][(l * 32 + g) * 64 + p], lim = C.ka->in[4][(l * 32 + g) * 64 + p], dt = expf(C.ka->in[5][l * 32 + g]);
    const float er = expf(32.f * lre * dt); float sn, cs; sincos_red(32.f * lim * dt, sn, cs);
    const float ar = er * cs, ai = er * sn;
    const unsigned* SN = (const unsigned*)(C.ws + WS_S5_SN) + ((size_t)(b * 128) * 32 + g) * 64 + p;
    unsigned* SP = (unsigned*)(C.ws + WS_S5_SP) + ((size_t)(b * 128) * 32 + g) * 64 + p;
    float sr = 0.f, si = 0.f;
    for (int n0 = 0; n0 < 128; n0 += 16) {
        unsigned v[16];
#pragma unroll
        for (int j = 0; j < 16; ++j) v[j] = SN[(size_t)(n0 + j) * 2048];
#pragma unroll
        for (int j = 0; j < 16; ++j) {
            SP[(size_t)(n0 + j) * 2048] = cvt_pk_bf16(sr, si);
            const float nr = ar * sr - ai * si + bflo(v[j]), ni = ar * si + ai * sr + bfhi(v[j]);
            sr = nr; si = ni;
        }
    }
}

__device__ __forceinline__ void s5_scan_block(const Ctx& C, int l, int b, int g) {
    const int p = (C.tid & 63), w = __builtin_amdgcn_readfirstlane(C.tid >> 6);
    const float lre = C.ka->in[3][(l * 32 + g) * 64 + p], lim = C.ka->in[4][(l * 32 + g) * 64 + p], dt = expf(C.ka->in[5][l * 32 + g]);
    const float er = expf(32.f * lre * dt); float sn, cs; sincos_red(32.f * lim * dt, sn, cs);
    const float ar = er * cs, ai = er * sn;
    const unsigned* SN = (const unsigned*)(C.ws + WS_S5_SN) + ((size_t)(b * 128 + 16 * w) * 32 + g) * 64 + p;
    unsigned* SP = (unsigned*)(C.ws + WS_S5_SP) + ((size_t)(b * 128 + 16 * w) * 32 + g) * 64 + p;
    LAS float* ex = (LAS float*)(C.lds + 49152);
    unsigned v[16];
#pragma unroll
    for (int j = 0; j < 16; ++j) v[j] = SN[(size_t)j * 2048];
    float sr = 0.f, si = 0.f;
#pragma unroll
    for (int j = 0; j < 16; ++j) { const float nr = ar * sr - ai * si + bflo(v[j]), ni = ar * si + ai * sr + bfhi(v[j]); sr = nr; si = ni; }
    ex[(w * 64 + p) * 2] = sr; ex[(w * 64 + p) * 2 + 1] = si;
    float pr = ar, pi = ai;
#pragma unroll
    for (int k = 0; k < 4; ++k) { const float qr = pr * pr - pi * pi, qi = 2.f * pr * pi; pr = qr; pi = qi; }
    __syncthreads();
    sr = 0.f; si = 0.f;
    for (int s = 0; s < w; ++s) { const float e0 = ex[(s * 64 + p) * 2], e1 = ex[(s * 64 + p) * 2 + 1]; const float nr = pr * sr - pi * si + e0, ni = pr * si + pi * sr + e1; sr = nr; si = ni; }
#pragma unroll
    for (int j = 0; j < 16; ++j) {
        SP[(size_t)j * 2048] = cvt_pk_bf16(sr, si);
        const float nr = ar * sr - ai * si + bflo(v[j]), ni = ar * si + ai * sr + bfhi(v[j]);
        sr = nr; si = ni;
    }
}
__device__ __forceinline__ void ret_scan2(const Ctx& C) {
    const int idx = (C.blk - 128) * NTHREADS + C.tid;
    const int bh = idx >> 13, el = idx & 8191, h = bh & 3;
    const float cd = exp2f(128.f * log2f(1.f - exp2f(-5.f - (float)h)));
    bf16_t* p0 = (bf16_t*)(C.ws + WS_KVS) + (size_t)bh * 32 * 8192 + el;
    bf16_t* p1 = p0 + (size_t)8 * 32 * 8192;
    float v0[32], v1[32];
#pragma unroll
    for (int n = 0; n < 32; ++n) { v0[n] = bf2f(p0[(size_t)n * 8192]); v1[n] = bf2f(p1[(size_t)n * 8192]); }
    float s0 = 0.f, s1 = 0.f;
#pragma unroll
    for (int n = 0; n < 32; ++n) { p0[(size_t)n * 8192] = f2bf(s0); p1[(size_t)n * 8192] = f2bf(s1); s0 = cd * s0 + v0[n]; s1 = cd * s1 + v1[n]; }
}

#define XB_IS_T0(b) ((b).w0 == 0 && lane_id_fresh() == 0)
#define XB_TMO      128
#define XB_XCNT(j)  (256  + 64 * (j))
#define XB_XSUB(j)  (1280 + 64 * (j))
#define XB_XGEN(j)  (2304 + 64 * (j))
#define XB_TOP      3328
#define XB_TOPGEN   3392
#define XCD_BAR_WORDS 3456
#define XB_SPIN_CAP (1u << 18)

__device__ __forceinline__ unsigned xb_ld(unsigned* p)              { return __hip_atomic_load(p, __ATOMIC_RELAXED, __HIP_MEMORY_SCOPE_AGENT); }
__device__ __forceinline__ unsigned xb_add(unsigned* p, unsigned v) { return __hip_atomic_fetch_add(p, v, __ATOMIC_RELAXED, __HIP_MEMORY_SCOPE_AGENT); }
__device__ __forceinline__ unsigned xb_xcc_id() { return (unsigned)__builtin_amdgcn_s_getreg((3 << 11) | 20) & 0xFu; }
#define XB_SPIN(cond, bar) do { unsigned _sp = 0; while (cond) { __builtin_amdgcn_s_sleep(1); \
    if ((++_sp & 255u) == 0u) { if (xb_ld(&(bar)[XB_TMO])) break; if (_sp > XB_SPIN_CAP) { atomicAdd(&(bar)[XB_TMO], 1u); break; } } } } while (0)

struct XcdBarrier {
    unsigned* bar; unsigned x; int w0;
    volatile LAS unsigned* st;
};

__device__ __forceinline__ XcdBarrier xcd_barrier_post(unsigned* bar, volatile LAS unsigned* st) {
    XcdBarrier b; b.bar = bar; b.x = xb_xcc_id(); b.st = st; b.w0 = __builtin_amdgcn_readfirstlane(threadIdx.x >> 6);
    if (threadIdx.x == 0) (void)xb_add(&bar[XB_XCNT(b.x)], 1u);
    return b;
}
__device__ __forceinline__ void xcd_barrier_complete(unsigned* bar, unsigned x, unsigned& nloc, unsigned& nx) {
    const unsigned G = gridDim.x * gridDim.y * gridDim.z;
    unsigned sum, cnt, mine, sp = 0u;
    for (;;) {
        sum = 0u; cnt = 0u; mine = 0u;
#pragma unroll
        for (unsigned j = 0; j < 16; ++j) { const unsigned c = xb_ld(&bar[XB_XCNT(j)]); sum += c; cnt += (c > 0u) ? 1u : 0u; mine = (j == x) ? c : mine; }
        if (sum == G) break;
        __builtin_amdgcn_s_sleep(1);
        if ((++sp & 255u) == 0u) { if (xb_ld(&bar[XB_TMO])) break; if (sp > XB_SPIN_CAP) { atomicAdd(&bar[XB_TMO], 1u); break; } }
    }
    nloc = mine > 0u ? mine : 1u; nx = cnt > 0u ? cnt : 1u;
}

__device__ __forceinline__ void xcd_barrier(const XcdBarrier& b) {
    asm volatile("s_waitcnt vmcnt(0)" ::: "memory");
    __syncthreads();
    if (XB_IS_T0(b)) {
        unsigned* bar = b.bar;
        __builtin_amdgcn_s_waitcnt(0);
        unsigned nloc = b.st[0], nx = b.st[1];
        if (nloc == 0u) { xcd_barrier_complete(bar, b.x, nloc, nx); b.st[0] = nloc; b.st[1] = nx; }
        const unsigned old = xb_add(&bar[XB_XSUB(b.x)], 1u);
        const unsigned gen = old / nloc;
        if (old + 1u == (gen + 1u) * nloc) {
            __builtin_amdgcn_fence(__ATOMIC_RELEASE, "agent");
            asm volatile("s_waitcnt vmcnt(0)" ::: "memory");
            const unsigned og = xb_add(&bar[XB_TOP], 1u);
            const unsigned tg = og / nx;
            if (og + 1u == (tg + 1u) * nx) xb_add(&bar[XB_TOPGEN], 1u);
            else XB_SPIN(xb_ld(&bar[XB_TOPGEN]) == tg, bar);
            __builtin_amdgcn_fence(__ATOMIC_ACQUIRE, "agent");
            xb_add(&bar[XB_XGEN(b.x)], 1u);
            asm volatile("s_waitcnt vmcnt(0)" ::: "memory");
        } else {
            XB_SPIN(xb_ld(&bar[XB_XGEN(b.x)]) == gen, bar);
            __builtin_amdgcn_fence(__ATOMIC_ACQUIRE, "agent");
            asm volatile("s_waitcnt vmcnt(0)" ::: "memory");
        }
    }
    __syncthreads();
}

__device__ __forceinline__ void fixup_tile(const Ctx& C, int l, int pm) {
    if ((pm & 15) == 0) return;
    const float* head = (const float*)(C.ws + WS_C); const float* tail = head + (size_t)64 * 2 * FF2;
    bf16_t* ACT = (bf16_t*)(C.ws + WS_D);
    const float* cw = C.ka->in[21] + (size_t)l * 3 * FF2; const float* cb = C.ka->in[22] + (size_t)l * FF2;
    for (int jh = C.tid; jh < FFH; jh += NTHREADS) {
        const int pn = jh >> 7, col = jh & 127;
        float o0[2], o1[2];
#pragma unroll
        for (int hf = 0; hf < 2; ++hf) {
            const int tc = pn * 256 + hf * 128 + col, wcn = hf * FFH + jh;
            const float hm2 = tail[(size_t)((pm - 1) * 2 + 0) * FF2 + tc], hm1 = tail[(size_t)((pm - 1) * 2 + 1) * FF2 + tc];
            const float h0 = head[(size_t)(pm * 2 + 0) * FF2 + tc], h1 = head[(size_t)(pm * 2 + 1) * FF2 + tc];
            const float w0 = cw[wcn], w1 = cw[FF2 + wcn], w2 = cw[2 * FF2 + wcn], bb = cb[wcn];
            o0[hf] = bb + w0 * hm2 + w1 * hm1 + w2 * h0; o1[hf] = bb + w0 * hm1 + w1 * h0 + w2 * h1;
        }
        ACT[(size_t)(pm * 256 + 0) * FFH + jh] = f2bf(siluf_(o0[0]) * o0[1]);
        ACT[(size_t)(pm * 256 + 1) * FFH + jh] = f2bf(siluf_(o1[0]) * o1[1]);
    }
}
constexpr int PH_PER_LAYER = 12, N_PHASES = 1 + 2 * PH_PER_LAYER;

__device__ __forceinline__ void phase_setup(const Ctx& C, int l) {
    for (int u = C.blk; u < 256; u += C.G) s5_gen_unit(C, l, u >> 3, u & 7);
    __syncthreads();
    phase_conv_a(C, l);
}
#define REOPAQUE_TID(T) int T; { unsigned z_ = (unsigned)C0.wave * 64u; asm volatile("" : "+s"(z_)); T = (int)__builtin_amdgcn_mbcnt_hi(~0u, __builtin_amdgcn_mbcnt_lo(~0u, z_)); asm volatile("" : "+v"(T)); }
__device__ __forceinline__ void run_phase(const Ctx& C0, int ph) {
    using namespace pg8;
    Ctx C = C0;
    { unsigned z_ = (unsigned)C0.wave * 64u; asm volatile("" : "+s"(z_)); int t = (int)__builtin_amdgcn_mbcnt_hi(~0u, __builtin_amdgcn_mbcnt_lo(~0u, z_)); asm volatile("" : "+v"(t)); C.tid = t; C.lane = t & 63; C.wave = __builtin_amdgcn_readfirstlane(t >> 6); }
    { CArgs* ka = (CArgs*)__builtin_amdgcn_kernarg_segment_ptr(); asm volatile("" : "+s"(ka)); C.ka = ka; C.out = ka->out; C.ws = ka->ws; }
    { int b = blockIdx.x, g = gridDim.x; asm volatile("" : "+s"(b), "+s"(g)); C.blk = b; C.G = g; }
#if TIMING
    const int sub = C.ka->sub;
#else
    const int sub = -1;
#endif
    if (ph == 0) { if (sub & 1) phase_prologue(C); __syncthreads(); if (sub & 2) { for (int u = C.blk; u < 256; u += C.G) s5_gen_unit(C, 0, u >> 3, u & 7); __syncthreads(); } if (sub & 4) phase_conv_a(C, 0); return; }
    const int l = (ph - 1) / PH_PER_LAYER, k = (ph - 1) % PH_PER_LAYER;
    bf16_t* WB = (bf16_t*)(C.ws + WS_B); bf16_t* WG = (bf16_t*)(C.ws + WS_FFW);
    float* ssq = (float*)(C.ws + WS_SSQ);
    switch (k) {
    case 0: break;
    case 1: {
        Gemm g = mkgemm((const bf16_t*)(C.ws + WS_C), 1024, WB + WB_WIN, 1024);
        const bool g256 = (C.G == 256); const bool up = C.blk >= 128;
        { TileListOrder S; S.list = g256 ? 0x765410ull : 0xDC765410ull; S.base.init(MTOK, (g256 ? 6 : 8) * 256, 1024, C.G, C.blk);
          if (g256) { if (up) S.range(256 + (C.blk - 128), 0, 1); else S.range(C.blk, 128, 2); } else S.range(C.blk, C.G, 1 << 20);
          EpiInProj<0> E{(bf16_t*)(C.ws + WS_D), ssq, C.ka->in[13] + l * 64, C.ka->in[14] + l * 64, (float*)(C.ws + WS_KMEAN)};
          gemm_phase(C.tid, C.lds, C.ldsx, g, S, E); }
        { TileListOrder S; S.base.init(MTOK, 4 * 256, 1024, C.G, C.blk); S.list = 0xBA98ull; S.range(C.blk, C.G, 1 << 20);
          EpiInProj<2> E{(bf16_t*)(C.ws + WS_D), ssq, C.ka->in[13] + l * 64, C.ka->in[14] + l * 64, (float*)(C.ws + WS_KMEAN)};
          REOPAQUE_TID(t2); gemm_phase(t2, C.lds, C.ldsx, g, S, E); }
        { TileListOrder S; S.base.init(MTOK, 2 * 256, 1024, C.G, C.blk); S.list = 0x32ull;
          if (g256) { if (up) S.range(C.blk - 128, 0, 1); else S.range(0, 0, 0); } else S.range(C.blk, C.G, 1 << 20);
          EpiInProj<1> E{(bf16_t*)(C.ws + WS_D), ssq, C.ka->in[13] + l * 64, C.ka->in[14] + l * 64, (float*)(C.ws + WS_KMEAN)};
          REOPAQUE_TID(t3); gemm_phase(t3, C.lds, C.ldsx, g, S, E); } } break;
    case 2: break;
    case 3: {
        { Gemm g = mkgemm((const bf16_t*)(C.ws + WS_D) + C_US, NNG, (const bf16_t*)(C.ws + WS_S5_BT1), 512);
          S5P1Order S{C.G, C.blk}; EpiS5P1 E{(bf16_t*)(C.ws + WS_S5_SN)};
          if (sub & 1) gemm_phase(C.tid, C.lds, C.ldsx, g, S, E); }
        __syncthreads();
        if (C.G == 256) {
            if (C.blk >= 128) { Gemm gv = mkgemm((const bf16_t*)(C.ws + WS_C), 1024, WB + WB_WIN, 1024);
                TileListOrder S; S.base.init(MTOK, 2 * 256, 1024, C.G, C.blk); S.list = 0xDCull; S.range(C.blk - 128, 0, 1);
                EpiInProj<0> E{(bf16_t*)(C.ws + WS_D), ssq, C.ka->in[13] + l * 64, C.ka->in[14] + l * 64, (float*)(C.ws + WS_KMEAN)};
                REOPAQUE_TID(tv); gemm_phase(tv, C.lds, C.ldsx, gv, S, E); }
            else if (sub & 2) for (int u = C.blk; u < 512; u += 128) ret_kv_unit(C, u >> 5, u & 31);
        } else
        if (sub & 2) for (int u = C.blk; u < 512; u += C.G) ret_kv_unit(C, u >> 5, u & 31);
        } break;
    case 4: {
        if (sub & 1) phase_select(C);
        if (C.G >= 256) { if (C.blk < 128) { if (sub & 4) s5_scan_block(C, l, C.blk >> 5, C.blk & 31); } else if (C.blk < 256) { if (sub & 2) ret_scan2(C); } }
        else { ret_scan(C);
        { const int gw = __builtin_amdgcn_readfirstlane(C.tid >> 6) * C.G + C.blk; if (gw < 128) s5_scan_unit(C, l, gw >> 5, gw & 31); } } } break;
    case 5: {
        { Gemm g = mkgemm((const bf16_t*)(C.ws + WS_D) + C_US, NNG, (const bf16_t*)(C.ws + WS_S5_BT2), 640);
          g.a[1].A = (const bf16_t*)(C.ws + WS_S5_SP); g.a[1].rs = 8192u; g.a[1].ts = 32u;
          S5P2Order S{C.G, C.blk}; EpiS5P2 E{(const bf16_t*)(C.ws + WS_D) + C_US, C.ka->in[10] + l * 512, (bf16_t*)(C.ws + WS_E)};
          if (sub & 1) gemm_phase(C.tid, C.lds, C.ldsx, g, S, E); }
        __syncthreads();
        { Ctx C2 = C; unsigned z_ = (unsigned)C0.wave * 64u; asm volatile("" : "+s"(z_)); int t = (int)__builtin_amdgcn_mbcnt_hi(~0u, __builtin_amdgcn_mbcnt_lo(~0u, z_)); asm volatile("" : "+v"(t)); C2.tid = t; C2.lane = t & 63; C2.wave = __builtin_amdgcn_readfirstlane(t >> 6);
          const attn_body::AttnTensors AT{(const bf16_t*)(C.ws + WS_D) + C_QA, (const bf16_t*)(C.ws + WS_D) + C_KA, (const bf16_t*)(C.ws + WS_D) + C_VA, (bf16_t*)(C.ws + WS_E) + 1024, (const unsigned short*)(C.ws + WS_SEL), (sub & 8) ? 0 : (1 | ((sub & 16) ? 2 : 0) | ((sub & 32) ? 4 : 0))};
          const attn_body::StaticOrder S(C2.G, C2.blk);
          if (sub & 2) attn_body::attn_phase<attn_body::StaticOrder>(C2.tid, (char*)C2.lds, AT, S); }
        __syncthreads();
        { Ctx C2 = C; unsigned z_ = (unsigned)C0.wave * 64u; asm volatile("" : "+s"(z_)); int t = (int)__builtin_amdgcn_mbcnt_hi(~0u, __builtin_amdgcn_mbcnt_lo(~0u, z_)); asm volatile("" : "+v"(t)); C2.tid = t; C2.lane = t & 63; C2.wave = __builtin_amdgcn_readfirstlane(t >> 6);
          if (!(sub & 4)) {} else if (C2.G == 256) {
              const int u0 = C2.blk < 128 ? C2.blk : 128 + 3 * (C2.blk - 128), nu = C2.blk < 128 ? 1 : 3;
              for (int u = u0; u < u0 + nu; ++u) ret_out_unit(C2, l, u >> 5, u & 31);
          } else { for (int u = C2.blk; u < 512; u += C2.G) ret_out_unit(C2, l, u >> 5, u & 31); } } } break;
    case 6: {
        if (sub & 1) { if (C.G == 256) { if (C.blk >= 128) { Ctx C3 = C; C3.blk = C.blk - 128; C3.G = 128; phase_conv_b(C3, l); } } else phase_conv_b(C, l); }
        __syncthreads();
        if (sub & 2) { Gemm g = mkgemm((const bf16_t*)(C.ws + WS_E), 1536, WB + WB_WGLU, 512); StaticOrder S; S.init(MTOK, 512, 512, C.G, C.blk);
          EpiGlu E{(const bf16_t*)(C.ws + WS_E), (bf16_t*)(C.ws + WS_F)};
          gemm_phase(C.tid, C.lds, C.ldsx, g, S, E); }
        if (sub & 4) { Gemm g = mkgemm((const bf16_t*)(C.ws + WS_C), 1024, WB + WB_WIN + (size_t)NNG * 1024, 1024); StaticOrder S; S.init(MTOK, NGATE, 1024, C.G, C.blk);
          EpiScaleAct E{(bf16_t*)(C.ws + WS_D), NGATE, ssq, 0, 0, 1, 0};
          gemm_phase(C.tid, C.lds, C.ldsx, g, S, E); } } break;
    case 7: {
        Gemm g = mkgemm((const bf16_t*)(C.ws + WS_E), 1536, WB + WB_WBR, 1536); g.a[1] = rowmajor((const bf16_t*)(C.ws + WS_F), 512);
        MergeOrder S; S.base.init(MTOK, 1024, 512, C.G, C.blk);
        EpiMerge E{(const bf16_t*)(C.ws + WS_D), (bf16_t*)(C.ws + WS_C)};
        gemm_phase(C.tid, C.lds, C.ldsx, g, S, E); } break;
    case 8: {
        Gemm g = mkgemm((const bf16_t*)(C.ws + WS_C), 1024, WB + WB_WO, 1024); StaticOrder S; S.init(MTOK, 1024, 1024, C.G, C.blk);
        EpiResid E{l == 0 ? C.ka->in[0] : C.out, C.out, (bf16_t*)(C.ws + WS_E), ssq, sub == 0};
        gemm_phase(C.tid, C.lds, C.ldsx, g, S, E); } break;
    case 9: {
        Gemm g = mkgemm((const bf16_t*)(C.ws + WS_E), 1024, WG + WG_WUP, 1024); StaticOrder S; S.init(MTOK, FF2, 1024, C.G, C.blk);
        float* head = (float*)(C.ws + WS_C); float* tail = head + (size_t)64 * 2 * FF2;
        EpiFfnUp E{(bf16_t*)(C.ws + WS_D), ssq, C.ka->in[21] + (size_t)l * 3 * FF2, C.ka->in[22] + (size_t)l * FF2, head, tail, sub == 0};
        gemm_phase(C.tid, C.lds, C.ldsx, g, S, E);
        if (l == 0 && C.G == 256 && C.blk >= 128 && sub != 0) { __syncthreads(); Ctx C3 = C; C3.blk = C.blk - 128; C3.G = 128; phase_conv_a(C3, 1); } } break;
    case 10: break;
    case 11: {
        Gemm g = mkgemm((const bf16_t*)(C.ws + WS_D), FFH, WG + WG_WD, FFH); StaticOrder S; S.init(MTOK, 1024, FFH, C.G, C.blk);
        { Unit u; for (int i = 0; S.next(i, u); ++i) fixup_tile(C, l, u.pm); }
        asm volatile("s_waitcnt vmcnt(0)" ::: "memory"); __syncthreads();
        EpiResid E{C.out, C.out, l == 0 ? (bf16_t*)(C.ws + WS_C) : nullptr, l == 0 ? ssq : nullptr, sub == 0};
        gemm_phase(C.tid, C.lds, C.ldsx, g, S, E);
        if (l == 0 && sub != 0) { __syncthreads(); if (C.G == 256) { for (int u = C.blk; u < 256; u += C.G) s5_gen_unit(C, 1, u >> 3, u & 7); } else phase_setup(C, 1); }
        } break;
    }
}

__global__ void __launch_bounds__(NTHREADS, 2) fwd_kernel(Args a) {
    extern __shared__ __attribute__((aligned(16))) unsigned char lds_raw[];
    Ctx C;
    C.lds = (LAS unsigned char*)lds_raw; C.ldsx = C.lds + RING_BYTES;
    C.tid = threadIdx.x; C.lane = C.tid & 63; C.wave = __builtin_amdgcn_readfirstlane(C.tid >> 6); C.G = gridDim.x; C.blk = blockIdx.x;
    C.ka = nullptr; C.out = nullptr; C.ws = nullptr;
#if MEGA
#if !NO_CG
    cg::grid_group grid = cg::this_grid();
#endif
    volatile LAS unsigned* bst = (volatile LAS unsigned*)(C.ldsx + 12288);
    if (threadIdx.x < 2) bst[threadIdx.x] = 0u;
    __syncthreads();
    XcdBarrier bar = xcd_barrier_post((unsigned*)a.ws, bst);
#endif
#if MEGA && NO_CG && STRAIGHT
#define PHX(k) run_phase(C, k); xcd_barrier(bar);
    PHX(0)
    PHX(2) PHX(4) PHX(5) PHX(6) PHX(7) PHX(8) PHX(9) PHX(10) PHX(12)
    PHX(14) PHX(16) PHX(17) PHX(18) PHX(19) PHX(20) PHX(21) PHX(22)
    run_phase(C, 24);
#undef PHX
#elif !MEGA && STRAIGHT
#define PHY(k) if (a.ph_lo == (k)) { run_phase(C, k); return; }
    PHY(0)
    PHY(2) PHY(4) PHY(5) PHY(6) PHY(7) PHY(8) PHY(9) PHY(10) PHY(12)
    PHY(14) PHY(16) PHY(17) PHY(18) PHY(19) PHY(20) PHY(21) PHY(22) PHY(24)
#undef PHY
#else
    for (int ph = a.ph_lo; ph < a.ph_hi; ++ph) {
        if (ph > 0 && ((ph - 1) % PH_PER_LAYER == 0 || (ph - 1) % PH_PER_LAYER == 2 || (ph - 1) % PH_PER_LAYER == 10)) continue;
        run_phase(C, ph);
#if MEGA
#if NO_CG
        if (ph + 1 < a.ph_hi) xcd_barrier(bar);
#else
        if (ph + 1 < a.ph_hi) { if (ph == a.ph_lo) grid.sync(); else xcd_barrier(bar); }
#endif
#endif
    }
#endif
}

__global__ void __launch_bounds__(NTHREADS, 2) naive_kernel(Args a, int which, int l) {
    Ctx C;
    C.lds = nullptr; C.ldsx = nullptr;
    C.tid = threadIdx.x; C.lane = C.tid & 63; C.wave = __builtin_amdgcn_readfirstlane(C.tid >> 6); C.G = gridDim.x; C.blk = blockIdx.x;
    C.ka = (CArgs*)__builtin_amdgcn_kernarg_segment_ptr(); C.out = a.out; C.ws = a.ws;
    if (which == 0) {
        const int u = __builtin_amdgcn_readfirstlane(C.tid >> 6) * C.G + C.blk;
        if (u < 128) s5_naive_unit(C, l, u >> 5, u & 31);
    } else if (which == 1) {
        const int u = __builtin_amdgcn_readfirstlane(C.tid >> 6) * C.G + C.blk;
        if (u < 32) ret_naive_unit(C, u >> 3, (u >> 1) & 3, u & 1);
        else if (u < 32 + 512) { const int v = u - 32; kmean_unit(C, v >> 7, (v >> 4) & 7, v & 15); }
    } else phase_mix3(C, l);
}
#ifdef DBG_CMP_PREP
__global__ void dbg_add_kernel(const float* v, float* out) { out[0] += 1000.f * v[0]; }
__global__ void dbg_prep_kernel(const float* x, const float* g1, const float* win, const float* qn, const float* kn, const unsigned short* P, const float* KM, float* res) {
    __shared__ float sh[64];
    const int d = threadIdx.x, idx = blockIdx.x, h = idx & 7, which = (idx >> 3) & 1, smp = idx >> 4;
    const int r = (smp * 997 + 31) & (MTOK - 1);
    float ssx = 0.f; for (int k = 0; k < 1024; ++k) { const float v = x[(size_t)r * 1024 + k]; ssx += v * v; }
    const float rs = rsqrtf(ssx / 1024.f + NORM_EPS);
    const int col = (which ? C_KA : C_QA) + h * 64 + d;
    float a = 0.f; for (int k = 0; k < 1024; ++k) a += x[(size_t)r * 1024 + k] * g1[k] * win[(size_t)k * NIN + col];
    a *= rs;
    sh[d] = a * a; __syncthreads();
    float ss = 0.f; for (int i = 0; i < 64; ++i) ss += sh[i];
    __syncthreads();
    float v = a * rsqrtf(ss / 64.f + NORM_EPS) * (which ? kn[d] : qn[d]);
    sh[d] = v; __syncthreads();
    const float t = (float)(r & (SEQ - 1));
    if (d < 16) { const int i = d & 7; const float inv = exp2f(-(float)i * (18.931568569324174f / 8.0f)); const float ang = t * inv; const float cs = cosf(ang), sn = sinf(ang);
        const float x1 = sh[i], x2 = sh[i + 8]; v = (d < 8) ? (x1 * cs - x2 * sn) : (x1 * sn + x2 * cs); }
    if (!which) v *= 0.125f * 1.4426950408889634f;
    const float st = __uint_as_float((unsigned)P[(size_t)r * NNG + col] << 16);
    float df = fabsf(v - st);
    if (which) df *= 0.18f;
    if (which && smp < 16) { const int b = smp & 3, jb = (smp >> 2) * 5; float m = 0.f;
        for (int i = 0; i < 256; ++i) m += __uint_as_float((unsigned)P[(size_t)(b * SEQ + jb * 256 + i) * NNG + C_KA + h * 64 + d] << 16);
        df = fmaxf(df, fabsf(m / 256.f - KM[((b * 8 + h) * 16 + jb) * 64 + d])); }
    sh[d] = df; __syncthreads();
    if (d == 0) { float mx = 0.f; for (int i = 0; i < 64; ++i) mx = fmaxf(mx, sh[i]); atomicMax((int*)res, __float_as_int(mx)); }
}
#endif
#if defined(DBG_CMP_RET) || defined(DBG_CMP_S5)
__global__ void dbg_add_kernel(const float* v, float* out) { out[0] += 1000.f * v[0]; }
__global__ void dbg_cmp2_kernel(const unsigned short* ya, int coff, const unsigned short* yb, int rows, float* out) {
    __shared__ float red[256];
    float m = 0.f;
    for (int i = threadIdx.x; i < rows * 512; i += 256) { const int r = i >> 9, c = i & 511;
        const float x = __uint_as_float((unsigned)ya[(size_t)r * 1536 + coff + c] << 16), y = __uint_as_float((unsigned)yb[(size_t)r * 512 + c] << 16);
        m = fmaxf(m, fabsf(x - y)); }
    red[threadIdx.x] = m; __syncthreads();
    for (int s = 128; s > 0; s >>= 1) { if (threadIdx.x < s) red[threadIdx.x] = fmaxf(red[threadIdx.x], red[threadIdx.x + s]); __syncthreads(); }
    if (threadIdx.x == 0) out[0] = red[0];
}
#endif
#ifdef DBG_CMP_MOBA
__global__ void dbg_add_kernel(const float* v, float* out) { out[0] += 1000.f * v[0]; }
__global__ void __launch_bounds__(NTHREADS, 2) dbg_moba_kernel(Args a) {
    Ctx C; C.lds = nullptr; C.ldsx = nullptr;
    C.tid = threadIdx.x; C.lane = C.tid & 63; C.wave = __builtin_amdgcn_readfirstlane(C.tid >> 6); C.G = gridDim.x; C.blk = blockIdx.x;
    C.ka = (CArgs*)__builtin_amdgcn_kernarg_segment_ptr(); C.out = a.out; C.ws = a.ws;
    const int gw = C.blk * NWAVES + __builtin_amdgcn_readfirstlane(C.tid >> 6), NGW = C.G * NWAVES;
    for (int u = gw; u < SEQ * 8; u += NGW) { const int h = u & 7, row = u >> 3; moba_naive_query(C, 0, h, row); }
}
__global__ void dbg_cmp_kernel(const unsigned short* ya, const unsigned short* yb, float* out) {
    __shared__ float red[256];
    float m = 0.f;
    for (int i = threadIdx.x; i < SEQ * 512; i += 256) { const int r = i >> 9, c = i & 511;
        const float x = __uint_as_float((unsigned)ya[(size_t)r * 1536 + 1024 + c] << 16), y = __uint_as_float((unsigned)yb[(size_t)r * 512 + c] << 16);
        m = fmaxf(m, fabsf(x - y)); }
    red[threadIdx.x] = m; __syncthreads();
    for (int s = 128; s > 0; s >>= 1) { if (threadIdx.x < s) red[threadIdx.x] = fmaxf(red[threadIdx.x], red[threadIdx.x + s]); __syncthreads(); }
    if (threadIdx.x == 0) out[0] = red[0];
}
#endif
__global__ void dbg_dump_kernel(const unsigned short* src, float* out, size_t n) {
    for (size_t i = (size_t)blockIdx.x * blockDim.x + threadIdx.x; i < n; i += (size_t)gridDim.x * blockDim.x) out[i] = __uint_as_float((unsigned)src[i] << 16);
}
extern "C" void kernel_launch(void* const* d_in, const int* in_sizes, int n_in, void* d_out, int out_size, void* d_ws, size_t ws_size, hipStream_t stream) {
    static int grid = 0;
    if (grid == 0) {
        if (n_in != 24 || out_size != MTOK * DM || ws_size < WS_END) { fprintf(stderr, "kernel_launch: unexpected shapes (n_in %d out %d ws %zu)\n", n_in, out_size, ws_size); grid = -1; return; }
        int dev = 0, cus = 0, per_cu = 0;
        hipGetDevice(&dev); hipDeviceGetAttribute(&cus, hipDeviceAttributeMultiprocessorCount, dev);
        hipFuncSetAttribute((const void*)fwd_kernel, hipFuncAttributeMaxDynamicSharedMemorySize, LDS_BYTES);
        hipOccupancyMaxActiveBlocksPerMultiprocessor(&per_cu, (const void*)fwd_kernel, NTHREADS, LDS_BYTES);
        (void)hipGetLastError();
        if (per_cu < 1) { fprintf(stderr, "kernel_launch: occupancy query says %d blocks per CU\n", per_cu); per_cu = 1; }
        grid = cus;
    }
    if (grid < 0) return;
#ifdef DBG_MEMSET
    hipMemsetAsync(d_ws, DBG_MEMSET, WS_END, stream);
#endif
    Args a{};
    for (int i = 0; i < 24; ++i) a.in[i] = (const float*)d_in[i];
    a.out = (float*)d_out; a.ws = (unsigned char*)d_ws; a.sub = -1;
#if MEGA
    hipMemsetAsync(d_ws, 0, 16384, stream);
    a.ph_lo = 0; a.ph_hi = N_PHASES;
#if NO_CG
    hipLaunchKernelGGL(fwd_kernel, dim3(grid), dim3(NTHREADS), LDS_BYTES, stream, a);
#else
    void* args[] = {&a};
    hipError_t e = hipLaunchCooperativeKernel((const void*)fwd_kernel, dim3(grid), dim3(NTHREADS), args, LDS_BYTES, stream);
    if (e != hipSuccess) fprintf(stderr, "cooperative launch failed: %s (grid %d)\n", hipGetErrorString(e), grid);
#endif
#else
#ifndef DBG_NPH
#define DBG_NPH N_PHASES
#endif
    for (int ph = 0; ph < DBG_NPH; ++ph) {
        a.ph_lo = ph; a.ph_hi = ph + 1;
        const int kk = ph == 0 ? -1 : (ph - 1) % PH_PER_LAYER, ll = ph == 0 ? 0 : (ph - 1) / PH_PER_LAYER;
        if (kk == 0 || kk == 2 || kk == 10) continue;
#ifdef DBG_CMP_S5
        if (kk == 3 && ll == 0) hipLaunchKernelGGL(naive_kernel, dim3(grid), dim3(NTHREADS), 0, stream, a, 0, ll);
#endif
#ifdef DBG_CMP_MOBA
        if (kk == 5 && ll == 0) hipLaunchKernelGGL(dbg_moba_kernel, dim3(grid), dim3(NTHREADS), 0, stream, a);
#endif
        hipLaunchKernelGGL(fwd_kernel, dim3(grid), dim3(NTHREADS), LDS_BYTES, stream, a);
#ifdef DBG_REPEAT_K
        if (kk == DBG_REPEAT_K) { Args a2 = a; a2.sub = DBG_REPEAT_SUB; for (int rep = 0; rep < DBG_REPEAT_N; ++rep) {
#ifdef DBG_REPEAT_PRE
            { Args a3 = a; a3.ph_lo = ph - 1; a3.ph_hi = ph; hipLaunchKernelGGL(fwd_kernel, dim3(grid), dim3(NTHREADS), LDS_BYTES, stream, a3); }
#endif
            hipLaunchKernelGGL(fwd_kernel, dim3(grid), dim3(NTHREADS), LDS_BYTES, stream, a2); } }
#endif
#ifdef DBG_CMP_PREP
        if (kk == 1 && ll == 0) { hipMemsetAsync(d_ws, 0, 4, stream);
            hipLaunchKernelGGL(dbg_prep_kernel, dim3(64 * 16), dim3(64), 0, stream, (const float*)d_in[0], (const float*)d_in[1], (const float*)d_in[2], (const float*)d_in[13], (const float*)d_in[14], (const unsigned short*)((unsigned char*)d_ws + WS_D), (const float*)((unsigned char*)d_ws + WS_KMEAN), (float*)d_ws); }
#endif
#ifdef DBG_CMP_S5
        if (kk == 5 && ll == 0) hipLaunchKernelGGL(dbg_cmp2_kernel, dim3(1), dim3(256), 0, stream, (const unsigned short*)((unsigned char*)d_ws + WS_E), 0, (const unsigned short*)((unsigned char*)d_ws + WS_G + 25 * MiB), 3072, (float*)d_ws);
#endif
#ifdef DBG_CMP_RET
        if (kk == 5 && ll == 0) hipLaunchKernelGGL(dbg_cmp2_kernel, dim3(1), dim3(256), 0, stream, (const unsigned short*)((unsigned char*)d_ws + WS_E), 512, (const unsigned short*)((unsigned char*)d_ws + WS_G + 25 * MiB), 3072, (float*)d_ws);
#endif
#ifdef DBG_CMP_MOBA
        if (kk == 5 && ll == 0) hipLaunchKernelGGL(dbg_cmp_kernel, dim3(1), dim3(256), 0, stream, (const unsigned short*)((unsigned char*)d_ws + WS_E), (const unsigned short*)((unsigned char*)d_ws + WS_G + 17 * MiB), (float*)d_ws);
#endif
        continue;
        hipLaunchKernelGGL(fwd_kernel, dim3(grid), dim3(NTHREADS), LDS_BYTES, stream, a);
    }
#if defined(DBG_CMP_MOBA) || defined(DBG_CMP_RET) || defined(DBG_CMP_S5) || defined(DBG_CMP_PREP)
    hipLaunchKernelGGL(dbg_add_kernel, dim3(1), dim3(1), 0, stream, (const float*)d_ws, (float*)d_out);
#endif
#ifdef DBG_DUMP_OFF
    hipLaunchKernelGGL(dbg_dump_kernel, dim3(2048), dim3(256), 0, stream, (const unsigned short*)((unsigned char*)d_ws + DBG_DUMP_OFF), (float*)d_out, (size_t)MTOK * DM);
#endif
#endif
}
```

```cpp
#include <hip/hip_runtime.h>
#include <hip/hip_cooperative_groups.h>
#include <cstdint>
#include <cstdio>
namespace cg = cooperative_groups;

#ifndef MEGA
#define MEGA 1
#endif
#ifndef NO_CG
#define NO_CG 1
#endif
#ifndef TIMING
#define TIMING 1
#endif
#ifndef STRAIGHT
#define STRAIGHT 1
#endif


#define LAS __attribute__((address_space(3)))
typedef unsigned short bf16_t;
typedef short bf16x8 __attribute__((ext_vector_type(8)));
typedef float f32x4 __attribute__((ext_vector_type(4)));
typedef float f32x2 __attribute__((ext_vector_type(2)));
typedef unsigned u32x4 __attribute__((ext_vector_type(4)));
typedef unsigned u32x2 __attribute__((ext_vector_type(2)));

constexpr int SEQ = 4096, DM = 1024, MTOK = 16384;
constexpr int NNG = 3584;
constexpr int C_US = 0, C_QR = 512, C_KR = 768, C_VR = 1024, C_GR = 1536, C_QA = 2048, C_KA = 2560, C_VA = 3072;
constexpr int NGATE = 3072, NIN = 6656, FFH = 2816, FF2 = 5632;
constexpr int NWAVES = 8, NTHREADS = 512;
constexpr float NORM_EPS = 1e-6f;

constexpr size_t MiB = 1u << 20;
constexpr size_t WS_SSQ = 256 * 1024;
constexpr size_t WS_KMEAN = 512 * 1024;
constexpr size_t WS_B = 1 * MiB;
constexpr size_t WB_WIN = 0, WB_WGLU = (size_t)NIN * 1024, WB_WBR = WB_WGLU + 512 * 512, WB_WO = WB_WBR + (size_t)1024 * 1536;
constexpr size_t WS_C = 20 * MiB;
constexpr size_t WS_D = 52 * MiB;
constexpr size_t WS_E = 164 * MiB;
constexpr size_t WS_HT = 196 * MiB;
constexpr size_t WS_F = 212 * MiB;
constexpr size_t WS_G = 228 * MiB;
constexpr size_t WS_FFW = 236 * MiB + 512 * 1024;
constexpr size_t WG_WUP = 0, WG_WD = (size_t)FF2 * 1024;
constexpr size_t WS_END = 256 * MiB;

__device__ __forceinline__ float bf2f(unsigned short h) { return __uint_as_float((unsigned)h << 16); }
__device__ __forceinline__ float bflo(unsigned w) { return __uint_as_float(w << 16); }
__device__ __forceinline__ float bfhi(unsigned w) { return __uint_as_float(w & 0xffff0000u); }
typedef __bf16 bf16x2_t __attribute__((ext_vector_type(2)));
__device__ __forceinline__ unsigned cvt_pk_bf16(float lo, float hi) { const f32x2 v = {lo, hi}; const bf16x2_t b = __builtin_convertvector(v, bf16x2_t); return __builtin_bit_cast(unsigned, b); }
__device__ __forceinline__ unsigned short f2bf(float f) { return (unsigned short)(cvt_pk_bf16(f, 0.f) & 0xffffu); }
__device__ __forceinline__ float fast_exp(float x) { return __builtin_amdgcn_exp2f(x * 1.4426950408889634f); }
__device__ __forceinline__ float sigmoidf_(float x) { x = fminf(fmaxf(x, -30.f), 30.f); return __builtin_amdgcn_rcpf(1.f + fast_exp(-x)); }
__device__ __forceinline__ float siluf_(float x) { return x * sigmoidf_(x); }
__device__ __forceinline__ float silu_nc(float x) { return x * __builtin_amdgcn_rcpf(1.f + fast_exp(-x)); }
__device__ __forceinline__ float gelu_tanh(float x) {
    const float t = x * fmaf(x * x, -0.10294324f, -2.3022082f);
    return x * __builtin_amdgcn_rcpf(1.f + __builtin_amdgcn_exp2f(t));
}
__device__ __forceinline__ void sincos_red(float a, float& s, float& c) {
    const float k = rintf(a * 0.15915494309189535f);
    float r = fmaf(-k, 6.2831854820251465f, a);
    r = fmaf(-k, -1.7484556000744883e-07f, r);
    s = __sinf(r); c = __cosf(r);
}
__device__ __forceinline__ int lane_id_fresh() { unsigned z = 0u; asm volatile("" : "+s"(z)); return (int)__builtin_amdgcn_mbcnt_hi(~0u, __builtin_amdgcn_mbcnt_lo(~0u, z)); }
template <class T> __device__ __forceinline__ T* at32(T* base, unsigned elem_off) { return (T*)((char*)base + (size_t)(elem_off * (unsigned)sizeof(T))); }
template <class T> __device__ __forceinline__ const T* at32(const T* base, unsigned elem_off) { return (const T*)((const char*)base + (size_t)(elem_off * (unsigned)sizeof(T))); }
__device__ __forceinline__ float readlane_f(float v, int l) { return __int_as_float(__builtin_amdgcn_readlane(__float_as_int(v), l)); }
__device__ __forceinline__ float shx(float v, int m, int lane) { return __int_as_float(__builtin_amdgcn_ds_bpermute((lane ^ m) << 2, __float_as_int(v))); }
__device__ __forceinline__ float wave_sum_l(float v, int lane) {
#pragma unroll
    for (int o = 1; o < 64; o <<= 1) v += shx(v, o, lane);
    return v;
}
__device__ __forceinline__ float wave_sum(float v) {
#pragma unroll
    for (int o = 1; o < 64; o <<= 1) v += __shfl_xor(v, o);
    return v;
}
__device__ __forceinline__ float wave_max(float v) {
#pragma unroll
    for (int o = 1; o < 64; o <<= 1) v = fmaxf(v, __shfl_xor(v, o));
    return v;
}
__device__ __forceinline__ float dpp_ror1(float x) { return __int_as_float(__builtin_amdgcn_mov_dpp(__float_as_int(x), 0x121, 0xF, 0xF, false)); }
__device__ __forceinline__ float dpp_shr1_old(float old, float x) { return __int_as_float(__builtin_amdgcn_update_dpp(__float_as_int(old), __float_as_int(x), 0x111, 0xF, 0xF, false)); }
__device__ __forceinline__ float dpp_shr2_old(float old, float x) { return __int_as_float(__builtin_amdgcn_update_dpp(__float_as_int(old), __float_as_int(x), 0x112, 0xF, 0xF, false)); }
__device__ __forceinline__ float dpp_ror2(float x) { return __int_as_float(__builtin_amdgcn_mov_dpp(__float_as_int(x), 0x122, 0xF, 0xF, false)); }
#define LDS_WAIT() asm volatile("s_waitcnt lgkmcnt(0)" ::: "memory")
#define WG_BAR() do { asm volatile("s_waitcnt lgkmcnt(0)" ::: "memory"); __builtin_amdgcn_s_barrier(); asm volatile("" ::: "memory"); } while (0)

namespace pg8 {
constexpr int BM = 256, BK = 64, HALF = 128, HTB = HALF * BK * 2, STAGE_BYTES = 8 * HTB, NXCD = 8, WGM = 8;
__host__ __device__ __forceinline__ int lds_byte(int r, int c) { const int st = (r >> 4) * 2 + (c >> 5), rr = r & 15, cc = c & 31, ob = rr * 64 + cc * 2; return st * 1024 + (ob ^ (((ob >> 9) & 1) << 5)); }
__host__ __device__ __forceinline__ void stage_rc(int b, int& R, int& C) { const int st = b / 1024, sb = b % 1024, swz = sb ^ (((sb >> 9) & 1) << 5); R = (st >> 1) * 16 + swz / 64; C = (st & 1) * 32 + (swz % 64) / 2; }
__host__ __device__ __forceinline__ int perm32(int rho) { const int n = rho >> 4, i = rho & 15; return 8 * (i >> 2) + 4 * n + (i & 3); }

struct Unit { int pm, pn, aux, nt, asel; long aoff, boff; };
struct ASpec { const bf16_t* A; unsigned rs, ts; };
struct Gemm { ASpec a[2]; const bf16_t* Bt; int ldb; };
__device__ __forceinline__ ASpec rowmajor(const bf16_t* A, int lda) { ASpec a; a.A = A; a.rs = 2u * (unsigned)lda; a.ts = 32u; return a; }
__device__ __forceinline__ Gemm mkgemm(const bf16_t* A, int lda, const bf16_t* Bt, int ldb) { Gemm g; g.a[0] = rowmajor(A, lda); g.a[1] = g.a[0]; g.Bt = Bt; g.ldb = ldb; return g; }

struct StaticOrder {
    int nM, nN, nwg, G, c, nt;
    __device__ __forceinline__ void init(int M, int N, int K, int G_, int c_) { nM = M / BM; nN = N / BM; nwg = nM * nN; G = G_; c = c_; nt = K / BK; }
    __device__ __forceinline__ bool next(int i, Unit& u) const { return map((long)i * G + c, u); }
    __device__ __forceinline__ bool map(long L, Unit& u) const {
        if (L >= nwg) return false;
        int wgid = (int)L; { const int q = nwg / NXCD, r = nwg % NXCD, xcd = wgid % NXCD, off = wgid / NXCD; wgid = (xcd < r ? xcd * (q + 1) : r * (q + 1) + (xcd - r) * q) + off; }
        const int nig = WGM * nN, gid = wgid / nig, fm = gid * WGM, gsz = (nM - fm) < WGM ? (nM - fm) : WGM;
        u.pm = fm + ((wgid % nig) % gsz); u.pn = (wgid % nig) / gsz; u.aux = 0; u.nt = nt; u.asel = 0; u.aoff = 0; u.boff = 0; return true;
    }
};
struct MergeOrder {
    StaticOrder base;
    __device__ __forceinline__ bool next(int i, Unit& u) const { const int r = i / 3, br = i - 3 * r; if (!base.next(r, u)) return false;
        u.aux = br; u.asel = (br == 0) ? 1 : 0; u.aoff = (br == 0) ? 0 : 1024 * br; u.boff = 1024 * br; return true; }
};
struct TileListOrder {
    StaticOrder base; unsigned long long list; int first, stride, count;
    __device__ __forceinline__ void range(int f, int s_, int n) { first = f; stride = s_; count = n; }
    __device__ __forceinline__ bool next(int i, Unit& u) const { if (i >= count || !base.map((long)first + (long)i * stride, u)) return false; u.pn = (int)((list >> (4 * u.pn)) & 15ull); return true; }
};
struct S5P1Order {
    int G, c;
    __device__ __forceinline__ bool next(int i, Unit& u) const { const int L = i * G + c; if (L >= 64) return false; const int g = L >> 1;
        u.pm = L & 1; u.pn = 0; u.aux = g; u.nt = 8; u.asel = 0; u.aoff = (long)g * 512 * NNG * 2; u.boff = (long)g * 128 * 512 * 2; return true; }
};
struct S5P2Order {
    int G, c;
    __device__ __forceinline__ bool next(int i, Unit& u) const { const int r = i >> 1, sub = i & 1; const int L = r * G + c; if (L >= 128) return false; const int g = L >> 2;
        u.pm = (L >> 1) & 1; u.pn = L & 1; u.aux = g * 2 + sub; u.nt = sub ? 2 : 8; u.asel = sub; u.aoff = sub ? 256 * g : (long)g * 512 * NNG * 2; u.boff = ((long)g * 512 * 640 + (sub ? 512 : 0)) * 2; return true; }
};

template <class Epi, class Sched>
__device__ __forceinline__ void gemm_phase(int tid, LAS unsigned char* lds, LAS unsigned char* ldsx, const Gemm g, const Sched& S, const Epi& E, const Unit chainu = Unit{}, bool chain = false, bool primed = false) {
    const int wid = __builtin_amdgcn_readfirstlane(tid >> 6), lane = tid & 63, wr = wid >> 2, wc = wid & 3, fr = lane & 15, fq = lane >> 4;
    unsigned voffA0[2], voffA1[2], voffB[2];
#pragma unroll
    for (int i = 0; i < 2; ++i) { int R, C; stage_rc(tid * 16 + i * 8192, R, C); const int Rb = (R & ~31) + perm32(R & 31);
        voffA0[i] = (unsigned)R * g.a[0].rs + (unsigned)(C >> 4) * g.a[0].ts + (unsigned)(C & 15) * 2u;
        voffA1[i] = (unsigned)R * g.a[1].rs + (unsigned)(C >> 4) * g.a[1].ts + (unsigned)(C & 15) * 2u;
        voffB[i] = (unsigned)(Rb * g.ldb + C) * 2u; }
    const size_t kstepB = (size_t)(BK * 2);
    const size_t hstepB = (size_t)HALF * g.ldb * 2, tstepB = 2 * hstepB;
    const unsigned ldsw = (unsigned)wid * 1024u;
    const int aoff = lds_byte(wr * 64 + fr, fq * 8), boff = lds_byte(wc * 32 + fr, fq * 8);
#define PG8_SA(b, h) (((b) * 2 + (h)) * HTB)
#define PG8_SB(b, h) ((4 + (b) * 2 + (h)) * HTB)
#define PG8_STAGE(bufoff, gbase, voff) do { _Pragma("unroll") for (int _i = 0; _i < 2; ++_i) \
        __builtin_amdgcn_global_load_lds((const unsigned*)((const char*)(gbase) + (voff)[_i]), (LAS unsigned*)(lds + (bufoff) + ldsw + _i * 8192), 16, 0, 0); } while (0)
#define PG8_LDA(dst, b, h) do { _Pragma("unroll") for (int m = 0; m < 4; ++m) _Pragma("unroll") for (int k = 0; k < 2; ++k) dst[m][k] = *(const LAS bf16x8*)(lds + PG8_SA(b, h) + aoff + m * 2048 + k * 1024); } while (0)
#define PG8_LDB(dst, b, h) do { _Pragma("unroll") for (int n = 0; n < 2; ++n) _Pragma("unroll") for (int k = 0; k < 2; ++k) dst[n][k] = *(const LAS bf16x8*)(lds + PG8_SB(b, h) + boff + n * 2048 + k * 1024); } while (0)
#define PG8_MMA(ai, bj, At, Bt) do { __builtin_amdgcn_s_setprio(1); _Pragma("unroll") for (int m = 0; m < 4; ++m) _Pragma("unroll") for (int n = 0; n < 2; ++n) _Pragma("unroll") for (int k = 0; k < 2; ++k) \
        acc[ai][bj][m][n] = __builtin_amdgcn_mfma_f32_16x16x32_bf16(Bt[n][k], At[m][k], acc[ai][bj][m][n], 0, 0, 0); __builtin_amdgcn_s_setprio(0); } while (0)
#define PG8_WAIT_V(n) asm volatile("s_waitcnt vmcnt(" #n ")" ::: "memory")
#define PG8_WAIT_L(n) asm volatile("s_waitcnt lgkmcnt(" #n ")" ::: "memory")
#define PG8_BAR __builtin_amdgcn_s_barrier()
#define PG8_SCHED __builtin_amdgcn_sched_barrier(0)
#define PG8_ABASE(u) ((const char*)((u).asel ? g.a[1].A : g.a[0].A) + (size_t)(u).pm * 256u * ((u).asel ? g.a[1].rs : g.a[0].rs) + (size_t)(u).aoff)
#define PG8_BBASE(u) ((const char*)g.Bt + (size_t)(u).pn * tstepB + (size_t)(u).boff)
    Unit cur, nxt; int ui = 0;
    if (!S.next(0, cur)) return;
    f32x4 acc[2][2][4][2];
#pragma unroll
    for (int a = 0; a < 2; ++a)
#pragma unroll
        for (int b = 0; b < 2; ++b)
#pragma unroll
            for (int m = 0; m < 4; ++m)
#pragma unroll
                for (int n = 0; n < 2; ++n) acc[a][b][m][n] = (f32x4){0.f, 0.f, 0.f, 0.f};
    bf16x8 At[4][2], B0[2][2], B1[2][2];
    const char* cA = PG8_ABASE(cur); const char* cB = PG8_BBASE(cur);
    unsigned cvA[2]; cvA[0] = cur.asel ? voffA1[0] : voffA0[0]; cvA[1] = cur.asel ? voffA1[1] : voffA0[1];
    size_t ckA = 4u * (size_t)(cur.asel ? g.a[1].ts : g.a[0].ts), chA = 128u * (size_t)(cur.asel ? g.a[1].rs : g.a[0].rs);
    int cnt = cur.nt;
    if (!primed) {
    PG8_STAGE(PG8_SB(0, 0), cB, voffB); PG8_STAGE(PG8_SB(0, 1), cB + hstepB, voffB); PG8_STAGE(PG8_SA(0, 0), cA, cvA); PG8_STAGE(PG8_SA(0, 1), cA + chA, cvA);
    if (wr == 1) PG8_BAR;
    PG8_WAIT_V(2); PG8_BAR;
    PG8_STAGE(PG8_SB(1, 0), cB + kstepB, voffB); PG8_STAGE(PG8_SA(1, 0), cA + ckA, cvA); PG8_STAGE(PG8_SB(1, 1), cB + hstepB + kstepB, voffB);
    PG8_WAIT_V(6); PG8_BAR;
    } else { if (wr == 1) PG8_BAR; }
    for (;;) {
        const bool has_next = S.next(ui + 1, nxt);
        if (!has_next && chain) nxt = chainu;
        const bool st_next = has_next || chain;
        const char* nA = st_next ? PG8_ABASE(nxt) : cA; const char* nB = st_next ? PG8_BBASE(nxt) : cB;
        unsigned nvA[2]; nvA[0] = st_next ? (nxt.asel ? voffA1[0] : voffA0[0]) : cvA[0]; nvA[1] = st_next ? (nxt.asel ? voffA1[1] : voffA0[1]) : cvA[1];
        const size_t nkA = st_next ? 4u * (size_t)(nxt.asel ? g.a[1].ts : g.a[0].ts) : ckA, nhA = st_next ? 128u * (size_t)(nxt.asel ? g.a[1].rs : g.a[0].rs) : chA;
        for (int t = 0; t < cnt; t += 2) {
            const bool last = (t == cnt - 2);
            const char* a1 = cA + (size_t)(t + 1) * ckA;
            const char* a2 = last ? nA : cA + (size_t)(t + 2) * ckA; const char* b2 = last ? nB : cB + (size_t)(t + 2) * kstepB;
            const size_t k2 = last ? nkA : ckA, h2 = last ? nhA : chA;
            unsigned v2[2]; v2[0] = last ? nvA[0] : cvA[0]; v2[1] = last ? nvA[1] : cvA[1];
            const char* a3 = a2 + k2; const char* b3 = b2 + kstepB;
            PG8_LDB(B0, 0, 0); PG8_LDB(B1, 0, 1); PG8_SCHED; PG8_LDA(At, 0, 0); PG8_STAGE(PG8_SA(1, 1), a1 + chA, cvA);
            PG8_WAIT_V(8); PG8_WAIT_L(0); PG8_BAR; PG8_MMA(0, 0, At, B0); PG8_MMA(0, 1, At, B1); PG8_BAR; PG8_SCHED;
            PG8_LDA(At, 0, 1); PG8_STAGE(PG8_SB(0, 0), b2, voffB); PG8_STAGE(PG8_SB(0, 1), b2 + hstepB, voffB); PG8_STAGE(PG8_SA(0, 0), a2, v2);
            PG8_WAIT_V(8); PG8_WAIT_L(0); PG8_BAR; PG8_MMA(1, 0, At, B0); PG8_MMA(1, 1, At, B1); PG8_BAR; PG8_SCHED;
            PG8_LDB(B0, 1, 0); PG8_LDB(B1, 1, 1); PG8_SCHED; PG8_LDA(At, 1, 0); PG8_STAGE(PG8_SA(0, 1), a2 + h2, v2);
            PG8_WAIT_V(8); PG8_WAIT_L(0); PG8_BAR; PG8_MMA(0, 0, At, B0); PG8_MMA(0, 1, At, B1); PG8_BAR; PG8_SCHED;
            PG8_LDA(At, 1, 1); PG8_STAGE(PG8_SB(1, 0), b3, voffB); PG8_STAGE(PG8_SB(1, 1), b3 + hstepB, voffB); PG8_STAGE(PG8_SA(1, 0), a3, v2);
            PG8_WAIT_V(8); PG8_WAIT_L(0); PG8_BAR; PG8_MMA(1, 0, At, B0); PG8_MMA(1, 1, At, B1); PG8_BAR; PG8_SCHED;
        }
        if (wr == 0) PG8_BAR;
        { int ln_ = lane_id_fresh(); asm volatile("" : "+v"(ln_));
          E(acc, cur, wr, wc, ln_ & 15, ln_ >> 4, wid, ln_, ldsx); }
        if (!has_next) break;
        if (!E.keep(cur)) {
#pragma unroll
            for (int a = 0; a < 2; ++a)
#pragma unroll
                for (int b = 0; b < 2; ++b)
#pragma unroll
                    for (int m = 0; m < 4; ++m)
#pragma unroll
                        for (int n = 0; n < 2; ++n) acc[a][b][m][n] = (f32x4){0.f, 0.f, 0.f, 0.f};
        }
        cur = nxt; cA = nA; cB = nB; cvA[0] = nvA[0]; cvA[1] = nvA[1]; ckA = nkA; chA = nhA; cnt = cur.nt; ++ui;
        if (wr == 1) PG8_BAR;
    }
    if (chain) return;
    PG8_WAIT_V(0);
    PG8_BAR;
#undef PG8_ABASE
#undef PG8_BBASE
#undef PG8_SA
#undef PG8_SB
#undef PG8_STAGE
#undef PG8_LDA
#undef PG8_LDB
#undef PG8_MMA
#undef PG8_WAIT_V
#undef PG8_WAIT_L
#undef PG8_BAR
#undef PG8_SCHED
}

typedef f32x4 Acc[2][2][4][2];

struct EpiScaleAct {
    bf16_t* O; int ldc; const float* ssq; int silu_lo, silu_hi, all_sig, us_tiles;
    __device__ __forceinline__ bool keep(const Unit&) const { return false; }
    __device__ __forceinline__ void operator()(Acc& acc, const Unit& u, int wr, int wc, int fr, int fq, int wid, int lane, LAS unsigned char* ldsx) const {
        const int row0 = u.pm * BM + wr * 64 + fr, col0 = u.pn * BM + wc * 32 + 8 * fq;
        const int act = all_sig ? 2 : ((u.pn >= silu_lo && u.pn < silu_hi) ? 1 : 0);
        f32x4 s4[8];
#pragma unroll
        for (int q = 0; q < 8; ++q) s4[q] = *(const f32x4*)(ssq + (size_t)(row0 + (q >> 2) * HALF + (q & 3) * 16) * 4);
        asm volatile("" ::: "memory");
#pragma unroll
        for (int ai = 0; ai < 2; ++ai)
#pragma unroll
            for (int m = 0; m < 4; ++m) {
                const int row = row0 + ai * HALF + m * 16;
                const f32x4 sq = s4[ai * 4 + m];
                const float rs = rsqrtf(((sq.x + sq.y) + (sq.z + sq.w)) * (1.0f / 1024.0f) + NORM_EPS);
#pragma unroll
                for (int bj = 0; bj < 2; ++bj) {
                    f32x4 v0, v1;
                    if (act == 2) {
                        const float rn = rs * -1.4426950408889634f;
#pragma unroll
                        for (int i = 0; i < 4; ++i) { v0[i] = __builtin_amdgcn_exp2f(fminf(acc[ai][bj][m][0][i] * rn, 43.f)); v1[i] = __builtin_amdgcn_exp2f(fminf(acc[ai][bj][m][1][i] * rn, 43.f)); }
                    } else { v0 = acc[ai][bj][m][0] * rs; v1 = acc[ai][bj][m][1] * rs;
                        if (act == 1) { for (int i = 0; i < 4; ++i) { v0[i] = siluf_(v0[i]); v1[i] = siluf_(v1[i]); } } }
                    u32x4 w; w.x = cvt_pk_bf16(v0[0], v0[1]); w.y = cvt_pk_bf16(v0[2], v0[3]); w.z = cvt_pk_bf16(v1[0], v1[1]); w.w = cvt_pk_bf16(v1[2], v1[3]);
                    if (u.pn < us_tiles) { const int ch = col0 + bj * HALF; *(u32x4*)(O + ((size_t)(ch >> 4) * 512 + (row >> 5)) * ldc + (row & 31) * 16 + (ch & 15)) = w; }
                    else *(u32x4*)at32(O, (unsigned)(row * ldc + col0 + bj * HALF)) = w;
                }
                asm volatile("" ::: "memory");
            }
    }
};
template <int KIND  > struct EpiInProj {
    bf16_t* O; const float* ssq; const float* qn; const float* kn; float* KM;
    __device__ __forceinline__ bool keep(const Unit&) const { return false; }
    __device__ __forceinline__ void operator()(Acc& acc, const Unit& u, int wr, int wc, int fr, int fq, int wid, int lane_, LAS unsigned char* ldsx) const {
        int lane = lane_; asm volatile("" : "+v"(lane));
        fq = lane >> 4; fr = lane & 15;
        const int row0 = u.pm * BM + wr * 64 + fr, col0 = u.pn * BM + wc * 32 + 8 * fq;
        const int pn = u.pn;
        f32x4 s4[8];
#pragma unroll
        for (int q = 0; q < 8; ++q) s4[q] = *(const f32x4*)((const char*)ssq + (unsigned)(row0 + (q >> 2) * HALF + (q & 3) * 16) * 16u);
        asm volatile("" ::: "memory");
#pragma unroll
        for (int ai = 0; ai < 2; ++ai)
#pragma unroll
            for (int m = 0; m < 4; ++m) { const f32x4 sq = s4[ai * 4 + m]; const float rs = rsqrtf(((sq.x + sq.y) + (sq.z + sq.w)) * (1.0f / 1024.0f) + NORM_EPS);
#pragma unroll
                for (int bj = 0; bj < 2; ++bj)
#pragma unroll
                    for (int n = 0; n < 2; ++n) acc[ai][bj][m][n] *= rs; }
        constexpr bool qk_ret = (KIND == 1), qk_att = (KIND == 2);
        if constexpr (qk_ret) {
            float inv[8];
#pragma unroll
            for (int e = 0; e < 8; ++e) inv[e] = exp2f(-(float)(8 * fq + e) * (13.287712379549449f / 31.0f));
            const float sc = (pn == 3) ? 0.125f : 1.0f;
#pragma unroll
            for (int ai = 0; ai < 2; ++ai)
#pragma unroll
                for (int m = 0; m < 4; ++m) {
                    const int row = row0 + ai * HALF + m * 16; const float t = (float)(row & (SEQ - 1));
#pragma unroll
                    for (int n = 0; n < 2; ++n) { f32x4 a = acc[ai][0][m][n], b = acc[ai][1][m][n];
#pragma unroll
                        for (int j = 0; j < 4; ++j) { float sn, cs; sincos_red(t * inv[4 * n + j], sn, cs); const float x1 = a[j], x2 = b[j]; a[j] = (x1 * cs - x2 * sn) * sc; b[j] = (x1 * sn + x2 * cs) * sc; }
                        asm volatile("" : "+v"(a), "+v"(b));
                        acc[ai][0][m][n] = a; acc[ai][1][m][n] = b; }
                }
        } else if constexpr (qk_att) {
            const float* gp = ((pn >= 10) ? kn : qn) + 8 * fq;
            const f32x4 g00 = *(const f32x4*)gp, g01 = *(const f32x4*)(gp + 4), g10 = *(const f32x4*)(gp + 32), g11 = *(const f32x4*)(gp + 36);
            float inv[8];
#pragma unroll
            for (int e = 0; e < 8; ++e) inv[e] = exp2f(-(float)e * (18.931568569324174f / 8.0f));
            const float sc = (pn < 10) ? 0.125f * 1.4426950408889634f : 1.0f;
            f32x4 cs0 = (f32x4){0.f, 0.f, 0.f, 0.f}, cs1 = cs0, cs2 = cs0, cs3 = cs0;
#pragma unroll
            for (int ai = 0; ai < 2; ++ai)
#pragma unroll
                for (int m = 0; m < 4; ++m) {
                    const int row = row0 + ai * HALF + m * 16; const float t = (float)(row & (SEQ - 1));
                    f32x4 a0 = acc[ai][0][m][0], a1 = acc[ai][0][m][1], b0 = acc[ai][1][m][0], b1 = acc[ai][1][m][1];
                    float ss = 0.f;
#pragma unroll
                    for (int j = 0; j < 4; ++j) ss += a0[j] * a0[j] + a1[j] * a1[j] + b0[j] * b0[j] + b1[j] * b1[j];
                    ss += shx(ss, 16, lane); ss += shx(ss, 32, lane);
                    const float r2 = rsqrtf(ss * (1.0f / 64.0f) + NORM_EPS);
                    a0 = a0 * r2 * g00; a1 = a1 * r2 * g01; b0 = b0 * r2 * g10; b1 = b1 * r2 * g11;
#pragma unroll
                    for (int n = 0; n < 2; ++n) { f32x4 own = n ? a1 : a0; f32x4 res = own;
#pragma unroll
                        for (int j = 0; j < 4; ++j) { const float oth = shx(own[j], 16, lane); float sn, cs; sincos_red(t * inv[4 * n + j], sn, cs);
                            res[j] = (fq == 0) ? (own[j] * cs - oth * sn) : (oth * sn + own[j] * cs); }
                        if (fq < 2) { if (n) a1 = res; else a0 = res; } }
                    a0 *= sc; a1 *= sc; b0 *= sc; b1 *= sc;
                    cs0 += a0; cs1 += a1; cs2 += b0; cs3 += b1;
                    asm volatile("" : "+v"(a0), "+v"(a1), "+v"(b0), "+v"(b1), "+v"(cs0), "+v"(cs1), "+v"(cs2), "+v"(cs3));
                    acc[ai][0][m][0] = a0; acc[ai][0][m][1] = a1; acc[ai][1][m][0] = b0; acc[ai][1][m][1] = b1;
                }
            if (pn >= 10) {
                float cv[16] = {cs0[0], cs0[1], cs0[2], cs0[3], cs1[0], cs1[1], cs1[2], cs1[3], cs2[0], cs2[1], cs2[2], cs2[3], cs3[0], cs3[1], cs3[2], cs3[3]};
#pragma unroll
                for (int e = 0; e < 16; ++e) { float v = cv[e]; v += shx(v, 1, lane); v += shx(v, 2, lane); v += shx(v, 4, lane); v += shx(v, 8, lane); cv[e] = v; }
                LAS float* R = (LAS float*)ldsx;
                if (fr == 0) {
#pragma unroll
                    for (int e = 0; e < 16; ++e) R[((wr * 4 + wc) * 4 + fq) * 16 + e] = cv[e]; }
                WG_BAR();
                if (wr == 0 && fr == 0) { const int head = 4 * (pn - 10) + wc, b = u.pm >> 4, jb = u.pm & 15;
                    float* km = KM + ((b * 8 + head) * 16 + jb) * 64;
#pragma unroll
                    for (int e = 0; e < 16; ++e) { const float v = (R[((0 * 4 + wc) * 4 + fq) * 16 + e] + R[((1 * 4 + wc) * 4 + fq) * 16 + e]) * (1.0f / 256.0f);
                        km[(e >> 3) * 32 + 8 * fq + (e & 7)] = v; } }
                WG_BAR();
            }
        }
        const int act = (KIND == 0 && (pn == 6 || pn == 7)) ? 1 : 0;
#pragma unroll
        for (int ai = 0; ai < 2; ++ai)
#pragma unroll
            for (int m = 0; m < 4; ++m) {
                const int row = row0 + ai * HALF + m * 16;
#pragma unroll
                for (int bj = 0; bj < 2; ++bj) {
                    f32x4 v0 = acc[ai][bj][m][0], v1 = acc[ai][bj][m][1];
                    if (act == 1) { for (int i = 0; i < 4; ++i) { v0[i] = siluf_(v0[i]); v1[i] = siluf_(v1[i]); } }
                    u32x4 w; w.x = cvt_pk_bf16(v0[0], v0[1]); w.y = cvt_pk_bf16(v0[2], v0[3]); w.z = cvt_pk_bf16(v1[0], v1[1]); w.w = cvt_pk_bf16(v1[2], v1[3]);
                    unsigned off;
                    if (KIND == 0 && pn < 2) { const int ch = col0 + bj * HALF; off = ((unsigned)((ch >> 4) * 512 + (row >> 5)) * NNG + (unsigned)((row & 31) * 16 + (ch & 15))) * 2u; }
                    else if (qk_ret || qk_att) off = ((unsigned)row * NNG + (unsigned)(pn * BM + wc * 64 + bj * 32 + 8 * fq)) * 2u;
                    else off = ((unsigned)row * NNG + (unsigned)(col0 + bj * HALF)) * 2u;
                    *(u32x4*)((char*)O + off) = w;
                }
                asm volatile("" ::: "memory");
            }
    }
};
struct EpiGlu {
    const bf16_t* Y; bf16_t* O;
    __device__ __forceinline__ bool keep(const Unit&) const { return false; }
    __device__ __forceinline__ void operator()(Acc& acc, const Unit& u, int wr, int wc, int fr, int fq, int wid, int lane, LAS unsigned char* ldsx) const {
        const int row0 = u.pm * BM + wr * 64 + fr, col0 = u.pn * BM + wc * 32 + 8 * fq;
        u32x4 yn[2];
#pragma unroll
        for (int bj = 0; bj < 2; ++bj) yn[bj] = *(const u32x4*)at32(Y, (unsigned)(row0 * 1536 + col0 + bj * HALF));
#pragma unroll
        for (int ai = 0; ai < 2; ++ai)
#pragma unroll
            for (int m = 0; m < 4; ++m) {
                const int row = row0 + ai * HALF + m * 16, q = ai * 4 + m;
                u32x4 yc[2]; yc[0] = yn[0]; yc[1] = yn[1];
                if (q < 7) { const int rown = row0 + ((q + 1) >> 2) * HALF + ((q + 1) & 3) * 16;
#pragma unroll
                    for (int bj = 0; bj < 2; ++bj) yn[bj] = *(const u32x4*)at32(Y, (unsigned)(rown * 1536 + col0 + bj * HALF)); }
                asm volatile("" ::: "memory");
#pragma unroll
                for (int bj = 0; bj < 2; ++bj) {
                    const u32x4 y = yc[bj];
                    const f32x4 a0 = acc[ai][bj][m][0], a1 = acc[ai][bj][m][1];
                    u32x4 w;
                    w.x = cvt_pk_bf16(bflo(y.x) * sigmoidf_(a0[0]), bfhi(y.x) * sigmoidf_(a0[1]));
                    w.y = cvt_pk_bf16(bflo(y.y) * sigmoidf_(a0[2]), bfhi(y.y) * sigmoidf_(a0[3]));
                    w.z = cvt_pk_bf16(bflo(y.z) * sigmoidf_(a1[0]), bfhi(y.z) * sigmoidf_(a1[1]));
                    w.w = cvt_pk_bf16(bflo(y.w) * sigmoidf_(a1[2]), bfhi(y.w) * sigmoidf_(a1[3]));
                    *(u32x4*)at32(O, (unsigned)(row * 512 + col0 + bj * HALF)) = w;
                }
                asm volatile("" ::: "memory");
            }
    }
};
struct EpiMerge {
    const bf16_t* G; bf16_t* O;
    __device__ __forceinline__ bool keep(const Unit& u) const { return u.aux < 2; }
    __device__ __forceinline__ void operator()(Acc& acc, const Unit& u, int wr, int wc, int fr, int fq, int wid, int lane, LAS unsigned char* ldsx) const {
        const int row0 = u.pm * BM + wr * 64 + fr, col0 = u.pn * BM + wc * 32 + 8 * fq; const int br = u.aux;
        const bf16_t* gbase = G + 1024 * br + col0;
        u32x4 gcn[2], gnn[2];
#pragma unroll
        for (int bj = 0; bj < 2; ++bj) { gcn[bj] = *(const u32x4*)at32(gbase, (unsigned)(row0 * NGATE + bj * HALF)); gnn[bj] = gcn[bj]; if (br < 2) gnn[bj] = *(const u32x4*)at32(gbase, (unsigned)(row0 * NGATE + bj * HALF + 1024)); }
#pragma unroll
        for (int ai = 0; ai < 2; ++ai)
#pragma unroll
            for (int m = 0; m < 4; ++m) {
                const int row = row0 + ai * HALF + m * 16, q = ai * 4 + m;
                u32x4 gcc[2], gnc[2]; gcc[0] = gcn[0]; gcc[1] = gcn[1]; gnc[0] = gnn[0]; gnc[1] = gnn[1];
                if (q < 7) { const size_t rown = (size_t)(row0 + ((q + 1) >> 2) * HALF + ((q + 1) & 3) * 16);
#pragma unroll
                    for (int bj = 0; bj < 2; ++bj) { gcn[bj] = *(const u32x4*)at32(gbase, (unsigned)rown * NGATE + bj * HALF); if (br < 2) gnn[bj] = *(const u32x4*)at32(gbase, (unsigned)rown * NGATE + bj * HALF + 1024); } }
                asm volatile("" ::: "memory");
#pragma unroll
                for (int bj = 0; bj < 2; ++bj) {
                    const u32x4 gc = gcc[bj];
                    float f[8] = {bflo(gc.x), bfhi(gc.x), bflo(gc.y), bfhi(gc.y), bflo(gc.z), bfhi(gc.z), bflo(gc.w), bfhi(gc.w)};
                    if (br < 2) {
                        const u32x4 gn = gnc[bj];
                        const float d[8] = {bflo(gn.x), bfhi(gn.x), bflo(gn.y), bfhi(gn.y), bflo(gn.z), bfhi(gn.z), bflo(gn.w), bfhi(gn.w)};
#pragma unroll
                        for (int i = 0; i < 8; ++i) f[i] = (1.f + d[i]) * __builtin_amdgcn_rcpf(1.f + f[i]);
                    } else {
#pragma unroll
                        for (int i = 0; i < 8; ++i) f[i] = __builtin_amdgcn_rcpf(1.f + f[i]);
                    }
                    f32x4 v0 = acc[ai][bj][m][0], v1 = acc[ai][bj][m][1];
#pragma unroll
                    for (int i = 0; i < 4; ++i) { v0[i] *= f[i]; v1[i] *= f[4 + i]; }
                    if (br < 2) { acc[ai][bj][m][0] = v0; acc[ai][bj][m][1] = v1; }
                    else { u32x4 w; w.x = cvt_pk_bf16(v0[0], v0[1]); w.y = cvt_pk_bf16(v0[2], v0[3]); w.z = cvt_pk_bf16(v1[0], v1[1]); w.w = cvt_pk_bf16(v1[2], v1[3]);
                        *(u32x4*)at32(O, (unsigned)(row * 1024 + col0 + bj * HALF)) = w; }
                }
            }
    }
};
struct EpiResid {
    const float* Xin; float* X; bf16_t* XB; float* ssq; int dry;
    __device__ __forceinline__ bool keep(const Unit&) const { return false; }
    __device__ __forceinline__ void operator()(Acc& acc, const Unit& u, int wr, int wc, int fr, int fq, int wid, int lane, LAS unsigned char* ldsx) const {
        const int row0 = u.pm * BM + wr * 64 + fr, col0 = u.pn * BM + wc * 32 + 8 * fq;
        LAS float* P = (LAS float*)ldsx;
        f32x4 xn[2][2];
#pragma unroll
        for (int bj = 0; bj < 2; ++bj) { const float* xp = at32(Xin, (unsigned)(row0 * 1024 + col0 + bj * HALF)); xn[bj][0] = *(const f32x4*)xp; xn[bj][1] = *(const f32x4*)(xp + 4); }
#pragma unroll
        for (int ai = 0; ai < 2; ++ai)
#pragma unroll
            for (int m = 0; m < 4; ++m) {
                const int row = row0 + ai * HALF + m * 16, q = ai * 4 + m; float sq = 0.f;
                f32x4 xc[2][2]; xc[0][0] = xn[0][0]; xc[0][1] = xn[0][1]; xc[1][0] = xn[1][0]; xc[1][1] = xn[1][1];
                if (q < 7) { const size_t rown = (size_t)(row0 + ((q + 1) >> 2) * HALF + ((q + 1) & 3) * 16);
#pragma unroll
                    for (int bj = 0; bj < 2; ++bj) { const float* xp = at32(Xin, (unsigned)rown * 1024 + col0 + bj * HALF); xn[bj][0] = *(const f32x4*)xp; xn[bj][1] = *(const f32x4*)(xp + 4); } }
                asm volatile("" ::: "memory");
#pragma unroll
                for (int bj = 0; bj < 2; ++bj) {
                    float* xp = at32(X, (unsigned)(row * 1024 + col0 + bj * HALF));
                    const f32x4 v0 = xc[bj][0] + acc[ai][bj][m][0], v1 = xc[bj][1] + acc[ai][bj][m][1];
                    if (!dry) { *(f32x4*)xp = v0; *(f32x4*)(xp + 4) = v1; }
                    sq += (v0[0] * v0[0] + v0[1] * v0[1]) + (v0[2] * v0[2] + v0[3] * v0[3]) + (v1[0] * v1[0] + v1[1] * v1[1]) + (v1[2] * v1[2] + v1[3] * v1[3]);
                    if (XB && !dry) { u32x4 w; w.x = cvt_pk_bf16(v0[0], v0[1]); w.y = cvt_pk_bf16(v0[2], v0[3]); w.z = cvt_pk_bf16(v1[0], v1[1]); w.w = cvt_pk_bf16(v1[2], v1[3]);
                        *(u32x4*)at32(XB, (unsigned)(row * 1024 + col0 + bj * HALF)) = w; }
                }
                sq += shx(sq, 16, lane); sq += shx(sq, 32, lane);
                if (fq == 0) P[(ai * HALF + wr * 64 + m * 16 + fr) * 4 + wc] = sq;
            }
        WG_BAR();
        const int tid_ = wid * 64 + lane;
        if (ssq && !dry && tid_ < 256) { const f32x4 p = *(const LAS f32x4*)(P + tid_ * 4); ssq[(size_t)(u.pm * BM + tid_) * 4 + u.pn] = (p.x + p.y) + (p.z + p.w); }
        WG_BAR();
    }
};
struct EpiFfnUp {
    bf16_t* ACT; const float* ssq; const float* cw; const float* cb; float* head; float* tail; int dry;
    __device__ __forceinline__ bool keep(const Unit&) const { return false; }
    __device__ __forceinline__ void operator()(Acc& acc, const Unit& u, int wr, int wc, int fr, int fq, int wid, int lane, LAS unsigned char* ldsx) const {
        if (dry) return;
        LAS float* XBf = (LAS float*)ldsx;
        const int row0 = u.pm * BM + wr * 64 + fr, cl = wc * 32 + 8 * fq;
        f32x4 cwn[4];
        {
            f32x4 s4[8];
#pragma unroll
            for (int q = 0; q < 8; ++q) s4[q] = *(const f32x4*)(ssq + (size_t)(row0 + (q >> 2) * HALF + (q & 3) * 16) * 4);
            { const int wcol = u.pn * HALF + cl;
              cwn[0] = *(const f32x4*)(cw + wcol); cwn[1] = *(const f32x4*)(cw + FF2 + wcol); cwn[2] = *(const f32x4*)(cw + 2 * FF2 + wcol); cwn[3] = *(const f32x4*)(cb + wcol); }
            asm volatile("" ::: "memory");
#pragma unroll
            for (int ai = 0; ai < 2; ++ai)
#pragma unroll
                for (int m = 0; m < 4; ++m) {
                    const f32x4 sq = s4[ai * 4 + m];
                    const float rs = rsqrtf(((sq.x + sq.y) + (sq.z + sq.w)) * (1.0f / 1024.0f) + NORM_EPS);
#pragma unroll
                    for (int bj = 0; bj < 2; ++bj)
#pragma unroll
                        for (int n = 0; n < 2; ++n) acc[ai][bj][m][n] *= rs;
                }
        }
        if (fr >= 14) {
#pragma unroll
            for (int ai = 0; ai < 2; ++ai)
#pragma unroll
                for (int bj = 0; bj < 2; ++bj)
#pragma unroll
                    for (int n = 0; n < 2; ++n) *(LAS f32x4*)(XBf + ((ai * 2 + wr) * 2 + (fr - 14)) * 256 + bj * HALF + cl + 4 * n) = acc[ai][bj][3][n];
            if (wr == 1) {
#pragma unroll
                for (int bj = 0; bj < 2; ++bj)
#pragma unroll
                    for (int n = 0; n < 2; ++n) *(f32x4*)(tail + (size_t)(u.pm * 2 + (fr - 14)) * FF2 + u.pn * BM + bj * HALF + cl + 4 * n) = acc[1][bj][3][n];
            }
        }
        if (wr == 0 && fr < 2) {
#pragma unroll
            for (int bj = 0; bj < 2; ++bj)
#pragma unroll
                for (int n = 0; n < 2; ++n) *(f32x4*)(head + (size_t)(u.pm * 2 + fr) * FF2 + u.pn * BM + bj * HALF + cl + 4 * n) = acc[0][bj][0][n];
        }
        WG_BAR();
#pragma unroll
        for (int bj = 0; bj < 2; ++bj)
#pragma unroll
            for (int n = 0; n < 2; ++n) {
                const f32x4 w0 = cwn[0], w1 = cwn[1], w2 = cwn[2], bb = cwn[3];
                if (bj * 2 + n < 3) { const int gq = bj * 2 + n + 1; const int wcol = (gq >> 1) * FFH + u.pn * HALF + cl + 4 * (gq & 1);
                    cwn[0] = *(const f32x4*)(cw + wcol); cwn[1] = *(const f32x4*)(cw + FF2 + wcol); cwn[2] = *(const f32x4*)(cw + 2 * FF2 + wcol); cwn[3] = *(const f32x4*)(cb + wcol); }
                asm volatile("" ::: "memory");
#pragma unroll
                for (int ai = 0; ai < 2; ++ai) {
                    const int s = ai * 2 + wr;
                    f32x4 pv = *(const LAS f32x4*)(XBf + ((s > 0 ? s - 1 : 0) * 2 + (fr & 1)) * 256 + bj * HALF + cl + 4 * n);
                    if (s == 0) pv = (f32x4){0.f, 0.f, 0.f, 0.f};
#pragma unroll
                    for (int m = 3; m >= 0; --m) {
                        const f32x4 prev = (m > 0) ? acc[ai][bj][m - 1][n] : pv;
                        const f32x4 c4 = acc[ai][bj][m][n]; f32x4 o4;
#pragma unroll
                        for (int i = 0; i < 4; ++i) {
                            const float cur = c4[i], p = prev[i];
                            const float h1 = dpp_shr1_old(dpp_ror1(p), cur), h2 = dpp_shr2_old(dpp_ror2(p), cur);
                            o4[i] = bb[i] + w0[i] * h2 + w1[i] * h1 + w2[i] * cur;
                        }
                        asm volatile("" : "+v"(o4));
                        acc[ai][bj][m][n] = o4;
                    }
                }
                asm volatile("" ::: "memory");
            }
#pragma unroll
        for (int ai = 0; ai < 2; ++ai)
#pragma unroll
            for (int m = 0; m < 4; ++m) {
                const int row = row0 + ai * HALF + m * 16;
                const f32x4 g0 = acc[ai][0][m][0], g1 = acc[ai][0][m][1], u0 = acc[ai][1][m][0], u1 = acc[ai][1][m][1];
                u32x4 w; w.x = cvt_pk_bf16(silu_nc(g0[0]) * u0[0], silu_nc(g0[1]) * u0[1]); w.y = cvt_pk_bf16(silu_nc(g0[2]) * u0[2], silu_nc(g0[3]) * u0[3]);
                w.z = cvt_pk_bf16(silu_nc(g1[0]) * u1[0], silu_nc(g1[1]) * u1[1]); w.w = cvt_pk_bf16(silu_nc(g1[2]) * u1[2], silu_nc(g1[3]) * u1[3]);
                *(u32x4*)at32(ACT, (unsigned)(row * FFH + u.pn * HALF + cl)) = w;
                asm volatile("" ::: "memory");
            }
        WG_BAR();
    }
};
struct EpiS5P1 {
    bf16_t* SN;
    __device__ __forceinline__ bool keep(const Unit&) const { return false; }
    __device__ __forceinline__ void operator()(Acc& acc, const Unit& u, int wr, int wc, int fr, int fq, int wid, int lane, LAS unsigned char* ldsx) const {
        const int row0 = u.pm * BM + wr * 64 + fr, g = u.aux;
#pragma unroll
        for (int ai = 0; ai < 2; ++ai)
#pragma unroll
            for (int m = 0; m < 4; ++m) {
                const int R = row0 + ai * HALF + m * 16;
                const f32x4 v0 = acc[ai][0][m][0], v1 = acc[ai][0][m][1];
                u32x4 w; w.x = cvt_pk_bf16(v0[0], v0[1]); w.y = cvt_pk_bf16(v0[2], v0[3]); w.z = cvt_pk_bf16(v1[0], v1[1]); w.w = cvt_pk_bf16(v1[2], v1[3]);
                *(u32x4*)(SN + ((size_t)R * 32 + g) * 128 + wc * 32 + 8 * fq) = w;
            }
    }
};
struct EpiS5P2 {
    const bf16_t* U; const float* dsk; bf16_t* Y;
    __device__ __forceinline__ bool keep(const Unit& u) const { return !(u.aux & 1); }
    __device__ __forceinline__ void operator()(Acc& acc, const Unit& u, int wr, int wc, int fr, int fq, int wid, int lane, LAS unsigned char* ldsx) const {
        if (!(u.aux & 1)) return;
        int fq_ = fq; asm volatile("" : "+v"(fq_));
        const int row0 = u.pm * BM + wr * 64 + fr, g = u.aux >> 1, h0 = 8 * (fq_ & 1);
        const f32x4 d0 = *(const f32x4*)(dsk + g * 16 + h0), d1 = *(const f32x4*)(dsk + g * 16 + h0 + 4);
#pragma unroll
        for (int ai = 0; ai < 2; ++ai)
#pragma unroll
            for (int m = 0; m < 4; ++m) {
                const int R = row0 + ai * HALF + m * 16;
#pragma unroll
                for (int bj = 0; bj < 2; ++bj) {
                    const int t = 16 * u.pn + 8 * bj + 2 * wc + (fq_ >> 1);
                    const size_t token = (size_t)R * 32 + t;
                    const u32x4 uu = *(const u32x4*)(U + ((size_t)g * 512 + R) * NNG + t * 16 + h0);
                    const f32x4 a0 = acc[ai][bj][m][0], a1 = acc[ai][bj][m][1];
                    u32x4 w;
                    w.x = cvt_pk_bf16(gelu_tanh(a0[0] + d0[0] * bflo(uu.x)), gelu_tanh(a0[1] + d0[1] * bfhi(uu.x)));
                    w.y = cvt_pk_bf16(gelu_tanh(a0[2] + d0[2] * bflo(uu.y)), gelu_tanh(a0[3] + d0[3] * bfhi(uu.y)));
                    w.z = cvt_pk_bf16(gelu_tanh(a1[0] + d1[0] * bflo(uu.z)), gelu_tanh(a1[1] + d1[1] * bfhi(uu.z)));
                    w.w = cvt_pk_bf16(gelu_tanh(a1[2] + d1[2] * bflo(uu.w)), gelu_tanh(a1[3] + d1[3] * bfhi(uu.w)));
                    *(u32x4*)(Y + token * 1536 + g * 16 + h0) = w;
                }
                asm volatile("" ::: "memory");
            }
    }
};
}

struct Args { const float* in[24]; float* out; unsigned char* ws; int ph_lo, ph_hi, sub, pad; };

typedef const __attribute__((address_space(4))) struct Args CArgs;
struct Ctx {
    LAS unsigned char* lds; LAS unsigned char* ldsx;
    int tid, lane, wave, G, blk;
    CArgs* ka; float* out; unsigned char* ws;
};
constexpr int RING_BYTES = 131072, LDSX_BYTES = 16384, LDS_BYTES = RING_BYTES + LDSX_BYTES;

__device__ __forceinline__ void transpose_item(const float* W, int N, const float* gk, bf16_t* WT, int ldd, int koff, int drow0, int dstep, LAS float* scr, int k0, int n0, int lane) {
    constexpr int ST = 66;
    f32x4 v[16];
#pragma unroll
    for (int i = 0; i < 16; ++i) v[i] = *(const f32x4*)(W + (size_t)(k0 + 4 * i + (lane >> 4)) * N + n0 + 4 * (lane & 15));
#pragma unroll
    for (int i = 0; i < 16; ++i) { const int kk = 4 * i + (lane >> 4); f32x4 x = v[i]; if (gk) x *= gk[k0 + kk];
        LAS f32x2* d = (LAS f32x2*)(scr + kk * ST + 4 * (lane & 15)); d[0] = (f32x2){x.x, x.y}; d[1] = (f32x2){x.z, x.w}; }
    LDS_WAIT(); asm volatile("" ::: "memory");
    const int c = lane & 7;
#pragma unroll
    for (int j = 0; j < 8; ++j) { const int n = (lane >> 3) + 8 * j; const LAS float* s = scr + (8 * c) * ST + n;
        u32x4 o; o.x = cvt_pk_bf16(s[0 * ST], s[1 * ST]); o.y = cvt_pk_bf16(s[2 * ST], s[3 * ST]); o.z = cvt_pk_bf16(s[4 * ST], s[5 * ST]); o.w = cvt_pk_bf16(s[6 * ST], s[7 * ST]);
        *(u32x4*)(WT + (size_t)(drow0 + (n & 31) + (n >> 5) * dstep) * ldd + koff + k0 + 8 * c) = o; }
    LDS_WAIT(); asm volatile("" ::: "memory");
}
__device__ __forceinline__ void convert_matrix(const Ctx& C, const float* W, int K, int N, const float* gk, bf16_t* WT, int ldd, int koff, int rowmode) {
    LAS float* scr = (LAS float*)(C.lds + __builtin_amdgcn_readfirstlane(C.tid >> 6) * 17408);
    const int gw = C.blk * NWAVES + __builtin_amdgcn_readfirstlane(C.tid >> 6), NGW = C.G * NWAVES;
    const int nblk = N / 64, items = (K / 64) * nblk;
    for (int it = gw; it < items; it += NGW) {
        const int kb = it / nblk, nb = it - kb * nblk, n0 = nb * 64;
        int drow0 = n0, dstep = 32;
        if (rowmode == 1) drow0 = (n0 < FFH) ? ((n0 >> 7) * 256 + (n0 & 127)) : (((n0 - FFH) >> 7) * 256 + 128 + ((n0 - FFH) & 127));
        if (rowmode == 2) { const int tile = n0 >> 8;
            if (tile == 2 || tile == 3 || (tile >= 8 && tile <= 11)) { drow0 = tile * 256 + 32 * ((n0 >> 6) & 3); dstep = 128; } }
        transpose_item(W, N, gk, WT, ldd, koff, drow0, dstep, scr, kb * 64, n0, (C.tid & 63));
    }
}

__device__ __forceinline__ void phase_prologue(const Ctx& C) {
    const int gw = C.blk * NWAVES + __builtin_amdgcn_readfirstlane(C.tid >> 6), NGW = C.G * NWAVES;
    const float* x = C.ka->in[0]; bf16_t* xb = (bf16_t*)(C.ws + WS_C); float* ssq = (float*)(C.ws + WS_SSQ);
    for (int r = gw; r < MTOK; r += NGW) {
        const f32x4* xr = (const f32x4*)(x + (size_t)r * DM) + (C.tid & 63);
        u32x2* brow = (u32x2*)(xb + (size_t)r * DM) + (C.tid & 63);
        f32x4 v[4];
#pragma unroll
        for (int j = 0; j < 4; ++j) v[j] = xr[64 * j];
        float s[4];
#pragma unroll
        for (int j = 0; j < 4; ++j) { u32x2 w; w.x = cvt_pk_bf16(v[j].x, v[j].y); w.y = cvt_pk_bf16(v[j].z, v[j].w); brow[64 * j] = w;
            s[j] = wave_sum_l((v[j].x * v[j].x + v[j].y * v[j].y) + (v[j].z * v[j].z + v[j].w * v[j].w), (C.tid & 63)); }
        if ((C.tid & 63) == 0) *(f32x4*)(ssq + (size_t)r * 4) = (f32x4){s[0], s[1], s[2], s[3]};
    }
}
__device__ __forceinline__ void phase_conv_a(const Ctx& C, int l) {
    bf16_t* WB = (bf16_t*)(C.ws + WS_B);
    LAS float* scr = (LAS float*)(C.lds + __builtin_amdgcn_readfirstlane(C.tid >> 6) * 17408);
    const int gw = C.blk * NWAVES + __builtin_amdgcn_readfirstlane(C.tid >> 6), NGW = C.G * NWAVES;
    for (int it = gw; it < 2368; it += NGW) {
        int j = it, m = 0;
        if (j >= 2112) { m = 5; j -= 2112; } else if (j >= 1728) { j -= 1728; m = 2 + (j >> 7); j &= 127; } else if (j >= 1664) { m = 1; j -= 1664; }
        const int N = (m == 0) ? NIN : (m == 1) ? 512 : 1024, nblk = N >> 6;
        const int inidx = (m == 0) ? 2 : (m == 1) ? 11 : (m == 5) ? 18 : 13 + m;
        const size_t lsz = (m == 0) ? (size_t)1024 * NIN : (m == 1) ? (size_t)512 * 512 : (m == 5) ? (size_t)1024 * 1024 : (size_t)512 * 1024;
        const float* W = C.ka->in[inidx] + (size_t)l * lsz;
        bf16_t* WT = WB + ((m == 0) ? WB_WIN : (m == 1) ? WB_WGLU : (m == 5) ? WB_WO : WB_WBR);
        const int ldd = (m == 1) ? 512 : (m >= 2 && m <= 4) ? 1536 : 1024, koff = (m >= 2 && m <= 4) ? 512 * (m - 2) : 0;
        const float* gk = (m == 0) ? C.ka->in[1] + l * 1024 : nullptr;
        const int kb = j / nblk, nb = j - kb * nblk, n0 = nb * 64;
        int drow0 = n0, dstep = 32;
        if (m == 0) { const int tile = n0 >> 8;
            if (tile == 2 || tile == 3 || (tile >= 8 && tile <= 11)) { drow0 = tile * 256 + 32 * ((n0 >> 6) & 3); dstep = 128; } }
        transpose_item(W, N, gk, WT, ldd, koff, drow0, dstep, scr, kb * 64, n0, (C.tid & 63));
    }
}
__device__ __forceinline__ void phase_conv_b(const Ctx& C, int l) {
    bf16_t* WG = (bf16_t*)(C.ws + WS_FFW);
    convert_matrix(C, C.ka->in[20] + (size_t)l * 1024 * FF2, 1024, FF2, C.ka->in[19] + l * 1024, WG + WG_WUP, 1024, 0, 1);
    convert_matrix(C, C.ka->in[23] + (size_t)l * FFH * 1024, FFH, 1024, nullptr, WG + WG_WD, FFH, 0, 0);
}

__device__ __forceinline__ void phase_mix1(const Ctx& C, int l) {
    const int gw = C.blk * NWAVES + __builtin_amdgcn_readfirstlane(C.tid >> 6), NGW = C.G * NWAVES, lane = (C.tid & 63);
    bf16_t* P = (bf16_t*)(C.ws + WS_D);
    const float* qn = C.ka->in[13] + l * 64; const float* kn = C.ka->in[14] + l * 64;
    for (int r = gw; r < MTOK; r += NGW) {
        const float t = (float)(r & (SEQ - 1));
        bf16_t* row = P + (size_t)r * NNG;
#pragma unroll
        for (int jj = 0; jj < 2; ++jj) {
            const int p = lane + 64 * jj, h = p >> 5, i = p & 31;
            const float inv = exp2f(-(float)i * (13.287712379549449f / 31.0f));
            float sn, cs; sincos_red(t * inv, sn, cs);
            bf16_t* q = row + C_QR + h * 64 + i; bf16_t* k = row + C_KR + h * 64 + i;
            const float q1 = bf2f(q[0]), q2 = bf2f(q[32]), k1 = bf2f(k[0]), k2 = bf2f(k[32]);
            q[0] = f2bf(q1 * cs - q2 * sn); q[32] = f2bf(q1 * sn + q2 * cs);
            k[0] = f2bf((k1 * cs - k2 * sn) * 0.125f); k[32] = f2bf((k1 * sn + k2 * cs) * 0.125f);
        }
        {
            const int which = lane >> 5, h = (lane >> 2) & 7, qt = lane & 3;
            bf16_t* p = row + (which ? C_KA : C_QA) + h * 64 + qt * 16;
            const float* gg = (which ? kn : qn) + qt * 16;
            const u32x4 a = *(const u32x4*)p, b = *(const u32x4*)(p + 8);
            float v[16] = {bflo(a.x), bfhi(a.x), bflo(a.y), bfhi(a.y), bflo(a.z), bfhi(a.z), bflo(a.w), bfhi(a.w), bflo(b.x), bfhi(b.x), bflo(b.y), bfhi(b.y), bflo(b.z), bfhi(b.z), bflo(b.w), bfhi(b.w)};
            float s = 0.f;
#pragma unroll
            for (int i = 0; i < 16; ++i) s += v[i] * v[i];
            s += shx(s, 1, lane); s += shx(s, 2, lane);
            const float rs = rsqrtf(s * (1.0f / 64.0f) + NORM_EPS);
#pragma unroll
            for (int i = 0; i < 16; ++i) v[i] = v[i] * rs * gg[i];
            const float qsc = which ? 1.0f : 0.125f * 1.4426950408889634f;
            if (qt == 0) {
#pragma unroll
                for (int i = 0; i < 8; ++i) {
                    const float inv = exp2f(-(float)i * (18.931568569324174f / 8.0f));
                    float sn, cs; sincos_red(t * inv, sn, cs);
                    const float x1 = v[i], x2 = v[i + 8];
                    v[i] = x1 * cs - x2 * sn; v[i + 8] = x1 * sn + x2 * cs;
                }
            }
#pragma unroll
            for (int i = 0; i < 16; ++i) v[i] *= qsc;
            u32x4 oa, ob;
            oa.x = cvt_pk_bf16(v[0], v[1]); oa.y = cvt_pk_bf16(v[2], v[3]); oa.z = cvt_pk_bf16(v[4], v[5]); oa.w = cvt_pk_bf16(v[6], v[7]);
            ob.x = cvt_pk_bf16(v[8], v[9]); ob.y = cvt_pk_bf16(v[10], v[11]); ob.z = cvt_pk_bf16(v[12], v[13]); ob.w = cvt_pk_bf16(v[14], v[15]);
            *(u32x4*)p = oa; *(u32x4*)(p + 8) = ob;
        }
    }
}

__device__ __forceinline__ void s5_naive_unit(const Ctx& C, int l, int b, int g) {
    const int lane = (C.tid & 63), p = lane, hl = lane & 15;
    const bf16_t* P = (const bf16_t*)(C.ws + WS_D); bf16_t* Y = (bf16_t*)(C.ws + WS_F);
    const float lre = C.ka->in[3][(l * 32 + g) * 64 + p], lim = C.ka->in[4][(l * 32 + g) * 64 + p], dt = expf(C.ka->in[5][l * 32 + g]);
    const float er = expf(lre * dt); float sn, cs; sincos_red(lim * dt, sn, cs);
    const float lbr = er * cs, lbi = er * sn;
    const float nr = lbr - 1.f, ni = lbi, den = lre * lre + lim * lim;
    const float cr = (nr * lre + ni * lim) / den, ci = (ni * lre - nr * lim) / den;
    float bbr[16], bbi[16], ccr[16], cci[16];
#pragma unroll
    for (int h = 0; h < 16; ++h) {
        const float br = C.ka->in[6][((size_t)(l * 32 + g) * 64 + p) * 16 + h], bi = C.ka->in[7][((size_t)(l * 32 + g) * 64 + p) * 16 + h];
        bbr[h] = cr * br - ci * bi; bbi[h] = cr * bi + ci * br;
        ccr[h] = C.ka->in[8][((size_t)(l * 32 + g) * 16 + h) * 64 + p]; cci[h] = C.ka->in[9][((size_t)(l * 32 + g) * 16 + h) * 64 + p];
    }
    const float dsk = C.ka->in[10][l * 512 + g * 16 + hl];
    float sr = 0.f, si = 0.f;
    const bf16_t* ubase = P + ((size_t)g * 512 + b * 128) * NNG + C_US + hl;
    float unext[4];
#pragma unroll
    for (int j = 0; j < 4; ++j) { const int tt = 4 * j + (lane >> 4); unext[j] = bf2f(ubase[(size_t)(tt >> 5) * NNG + (tt & 31) * 16]); }
    for (int t0 = 0; t0 < SEQ; t0 += 16) {
        float ucur[4];
#pragma unroll
        for (int j = 0; j < 4; ++j) ucur[j] = unext[j];
        if (t0 + 16 < SEQ) {
#pragma unroll
            for (int j = 0; j < 4; ++j) { const int tt = t0 + 16 + 4 * j + (lane >> 4); unext[j] = bf2f(ubase[(size_t)(tt >> 5) * NNG + (tt & 31) * 16]); }
        }
#pragma unroll
        for (int sj = 0; sj < 4; ++sj) {
          const float ureg = ucur[sj];
#pragma unroll 1
          for (int ss = 0; ss < 4; ++ss) {
            const int s = sj * 4 + ss;
            float bur = 0.f, bui = 0.f;
#pragma unroll
            for (int h = 0; h < 16; ++h) { const float uh = readlane_f(ureg, ss * 16 + h); bur = fmaf(bbr[h], uh, bur); bui = fmaf(bbi[h], uh, bui); }
            const float nsr = lbr * sr - lbi * si + bur, nsi = lbr * si + lbi * sr + bui;
            sr = nsr; si = nsi;
            float z[16];
#pragma unroll
            for (int h = 0; h < 16; ++h) z[h] = ccr[h] * sr - cci[h] * si;
            float w8[8], w4[4], w2[2], w1;
            { const bool hi = lane & 1;
#pragma unroll
              for (int j = 0; j < 8; ++j) { const float keep = hi ? z[2 * j + 1] : z[2 * j], send = hi ? z[2 * j] : z[2 * j + 1]; w8[j] = keep + __shfl_xor(send, 1); } }
            { const bool hi = lane & 2;
#pragma unroll
              for (int j = 0; j < 4; ++j) { const float keep = hi ? w8[2 * j + 1] : w8[2 * j], send = hi ? w8[2 * j] : w8[2 * j + 1]; w4[j] = keep + __shfl_xor(send, 2); } }
            { const bool hi = lane & 4;
#pragma unroll
              for (int j = 0; j < 2; ++j) { const float keep = hi ? w4[2 * j + 1] : w4[2 * j], send = hi ? w4[2 * j] : w4[2 * j + 1]; w2[j] = keep + __shfl_xor(send, 4); } }
            { const bool hi = lane & 8; const float keep = hi ? w2[1] : w2[0], send = hi ? w2[0] : w2[1]; w1 = keep + __shfl_xor(send, 8); }
            w1 += __shfl_xor(w1, 16); w1 += __shfl_xor(w1, 32);
            const float ul = __shfl(ureg, ss * 16 + hl);
            const float y = w1 + dsk * ul;
#ifdef DBG_CMP_S5
            if (lane < 16 && b == 0 && t0 + s < 3072) ((bf16_t*)(C.ws + WS_G + 25 * MiB))[(size_t)(t0 + s) * 512 + g * 16 + lane] = f2bf(gelu_tanh(y));
#else
            if (lane < 16) Y[(size_t)(b * SEQ + t0 + s) * 512 + g * 16 + lane] = f2bf(gelu_tanh(y));
#endif
          }
        }
    }
}
__device__ __forceinline__ void ret_naive_unit(const Ctx& C, int b, int h, int eh) {
    const int lane = (C.tid & 63), e = eh * 64 + lane;
    const bf16_t* P = (const bf16_t*)(C.ws + WS_D); bf16_t* O = (bf16_t*)(C.ws + WS_G);
    const float gamma = 1.f - exp2f(-5.f - (float)h);
    float S[64];
#pragma unroll
    for (int d = 0; d < 64; ++d) S[d] = 0.f;
    const bf16_t* base = P + (size_t)b * SEQ * NNG;
    float qn[4], kn[4], vn[4];
#pragma unroll
    for (int j = 0; j < 4; ++j) { const bf16_t* r = base + (size_t)j * NNG; qn[j] = bf2f(r[C_QR + h * 64 + lane]); kn[j] = bf2f(r[C_KR + h * 64 + lane]); vn[j] = bf2f(r[C_VR + h * 128 + e]); }
    for (int t0 = 0; t0 < SEQ; t0 += 4) {
        float qc[4], kc[4], vc[4];
#pragma unroll
        for (int j = 0; j < 4; ++j) { qc[j] = qn[j]; kc[j] = kn[j]; vc[j] = vn[j]; }
        if (t0 + 4 < SEQ) {
#pragma unroll
            for (int j = 0; j < 4; ++j) { const bf16_t* r = base + (size_t)(t0 + 4 + j) * NNG; qn[j] = bf2f(r[C_QR + h * 64 + lane]); kn[j] = bf2f(r[C_KR + h * 64 + lane]); vn[j] = bf2f(r[C_VR + h * 128 + e]); }
        }
#pragma unroll
        for (int j = 0; j < 4; ++j) {
            float o = 0.f;
#pragma unroll
            for (int d = 0; d < 64; ++d) {
                const float kd = readlane_f(kc[j], d), qd = readlane_f(qc[j], d);
                S[d] = fmaf(gamma, S[d], kd * vc[j]);
                o = fmaf(qd, S[d], o);
            }
            O[(size_t)(b * SEQ + t0 + j) * 512 + h * 128 + e] = f2bf(o);
        }
    }
}
__device__ __forceinline__ void kmean_unit(const Ctx& C, int b, int h, int j) {
    const bf16_t* P = (const bf16_t*)(C.ws + WS_D); float* KM = (float*)(C.ws + WS_KMEAN);
    const bf16_t* kp = P + (size_t)(b * SEQ + j * 256) * NNG + C_KA + h * 64 + (C.tid & 63);
    float s0 = 0.f, s1 = 0.f, s2 = 0.f, s3 = 0.f;
#pragma unroll 8
    for (int i = 0; i < 256; i += 4) { s0 += bf2f(kp[(size_t)i * NNG]); s1 += bf2f(kp[(size_t)(i + 1) * NNG]); s2 += bf2f(kp[(size_t)(i + 2) * NNG]); s3 += bf2f(kp[(size_t)(i + 3) * NNG]); }
    KM[((b * 8 + h) * 16 + j) * 64 + (C.tid & 63)] = ((s0 + s1) + (s2 + s3)) * (1.0f / 256.0f);
}
__device__ __forceinline__ void phase_mix2(const Ctx& C, int l) {
    const int gw = __builtin_amdgcn_readfirstlane(C.tid >> 6) * C.G + C.blk, NGW = C.G * NWAVES;
    (void)NGW;
    const int u = gw;
    if (u < 128) s5_naive_unit(C, l, u >> 5, u & 31);
    else if (u < 160) { const int v = u - 128; ret_naive_unit(C, v >> 3, (v >> 1) & 3, v & 1); }
    else if (u < 672) { const int v = u - 160; kmean_unit(C, v >> 7, (v >> 4) & 7, v & 15); }
}
__device__ __forceinline__ void ret_finalize_row(const Ctx& C, int l, int r) {
    const int lane = (C.tid & 63), h = lane >> 4, e0 = (lane & 15) * 8;
    const bf16_t* O = (const bf16_t*)(C.ws + WS_G); const bf16_t* P = (const bf16_t*)(C.ws + WS_D); bf16_t* Y = (bf16_t*)(C.ws + WS_E);
    const u32x4 a = *(const u32x4*)(O + (size_t)r * 512 + h * 128 + e0);
    float v[8] = {bflo(a.x), bfhi(a.x), bflo(a.y), bfhi(a.y), bflo(a.z), bfhi(a.z), bflo(a.w), bfhi(a.w)};
    float s = 0.f;
#pragma unroll
    for (int i = 0; i < 8; ++i) s += v[i];
    s += __shfl_xor(s, 1); s += __shfl_xor(s, 2); s += __shfl_xor(s, 4); s += __shfl_xor(s, 8);
    const float mu = s * (1.0f / 128.0f); float q = 0.f;
#pragma unroll
    for (int i = 0; i < 8; ++i) { v[i] -= mu; q += v[i] * v[i]; }
    q += __shfl_xor(q, 1); q += __shfl_xor(q, 2); q += __shfl_xor(q, 4); q += __shfl_xor(q, 8);
    const float rs = rsqrtf(q * (1.0f / 128.0f) + NORM_EPS);
    const u32x4 gsil = *(const u32x4*)(P + (size_t)r * NNG + C_GR + h * 128 + e0);
    const float gs[8] = {bflo(gsil.x), bfhi(gsil.x), bflo(gsil.y), bfhi(gsil.y), bflo(gsil.z), bfhi(gsil.z), bflo(gsil.w), bfhi(gsil.w)};
    const float* gn = C.ka->in[12] + l * 512 + h * 128 + e0;
    float o[8];
#pragma unroll
    for (int i = 0; i < 8; ++i) o[i] = gs[i] * (v[i] * rs * gn[i]);
    u32x4 w; w.x = cvt_pk_bf16(o[0], o[1]); w.y = cvt_pk_bf16(o[2], o[3]); w.z = cvt_pk_bf16(o[4], o[5]); w.w = cvt_pk_bf16(o[6], o[7]);
#ifdef DBG_CMP_RET
    if (r < 3072) *(u32x4*)((bf16_t*)(C.ws + WS_G + 25 * MiB) + (size_t)r * 512 + h * 128 + e0) = w;
#else
    *(u32x4*)(Y + (size_t)r * 1536 + 512 + h * 128 + e0) = w;
#endif
}
__device__ __forceinline__ void moba_naive_query(const Ctx& C, int b, int h, int t) {
    const int lane = (C.tid & 63);
    const bf16_t* P = (const bf16_t*)(C.ws + WS_D); const float* KM = (const float*)(C.ws + WS_KMEAN); bf16_t* Y = (bf16_t*)(C.ws + WS_E);
    const size_t rowq = (size_t)(b * SEQ + t);
    const float qv = bf2f(P[rowq * NNG + C_QA + h * 64 + lane]);
    float q[64];
#pragma unroll
    for (int d = 0; d < 64; ++d) q[d] = readlane_f(qv, d);
    const int qblk = t >> 8;
    float gate = -3.0e38f;
    if (lane < 16) {
        const float* km = KM + ((b * 8 + h) * 16 + lane) * 64; float s = 0.f;
#pragma unroll
        for (int d = 0; d < 64; d += 4) { const f32x4 k4 = *(const f32x4*)(km + d); s += q[d] * k4.x + q[d + 1] * k4.y + q[d + 2] * k4.z + q[d + 3] * k4.w; }
        if (lane < qblk) gate = s;
    }
    int segblk[4]; const int nsel = qblk < 3 ? qblk : 3;
#pragma unroll
    for (int s = 0; s < 3; ++s) {
        segblk[s] = 0;
        if (s < nsel) {
            const float mx = wave_max(gate);
            const unsigned long long bal = __ballot(gate == mx && lane < 16);
            const int j = (int)__builtin_ctzll(bal);
            segblk[s] = j;
            if (lane == j) gate = -3.0e38f;
        }
    }
    segblk[3] = qblk;
    float sc[16]; float mx = -3.0e38f;
#pragma unroll
    for (int s = 0; s < 4; ++s) {
        const bool segon = (s == 3) || (s < nsel);
#pragma unroll
        for (int i = 0; i < 4; ++i) {
            float v = -3.0e38f;
            if (segon) {
                const int key = segblk[s] * 256 + 64 * i + lane;
                if (s < 3 || key <= t) {
                    const bf16_t* kp = P + (size_t)(b * SEQ + key) * NNG + C_KA + h * 64; float a = 0.f;
#pragma unroll
                    for (int d = 0; d < 64; d += 8) { const u32x4 k8 = *(const u32x4*)(kp + d);
                        a += q[d] * bflo(k8.x) + q[d + 1] * bfhi(k8.x) + q[d + 2] * bflo(k8.y) + q[d + 3] * bfhi(k8.y) + q[d + 4] * bflo(k8.z) + q[d + 5] * bfhi(k8.z) + q[d + 6] * bflo(k8.w) + q[d + 7] * bfhi(k8.w); }
                    v = a;
                }
            }
            sc[s * 4 + i] = v; mx = fmaxf(mx, v);
        }
    }
    mx = wave_max(mx);
    float sum = 0.f;
#pragma unroll
    for (int i = 0; i < 16; ++i) { sc[i] = (sc[i] > -1.0e38f) ? __builtin_amdgcn_exp2f(sc[i] - mx) : 0.f; sum += sc[i]; }
    sum = wave_sum(sum);
    float o = 0.f;
#pragma unroll
    for (int s = 0; s < 4; ++s) {
        const bool segon = (s == 3) || (s < nsel);
        if (segon) {
#pragma unroll
            for (int i = 0; i < 4; ++i) {
                const bf16_t* vp = P + (size_t)(b * SEQ + segblk[s] * 256 + 64 * i) * NNG + C_VA + h * 64 + lane;
                const float pr = sc[s * 4 + i];
#pragma unroll 8
                for (int kk = 0; kk < 64; ++kk) { const float pk = __shfl(pr, kk); o = fmaf(pk, bf2f(vp[(size_t)kk * NNG]), o); }
            }
        }
    }
#ifdef DBG_CMP_MOBA
    ((bf16_t*)(C.ws + WS_G + 17 * MiB))[rowq * 512 + h * 64 + lane] = f2bf(o / sum);
#else
    Y[rowq * 1536 + 1024 + h * 64 + lane] = f2bf(o / sum);
#endif
}
__device__ __forceinline__ void phase_mix3(const Ctx& C, int l) {
    const int gw = C.blk * NWAVES + __builtin_amdgcn_readfirstlane(C.tid >> 6), NGW = C.G * NWAVES;
    for (int r = gw; r < MTOK; r += NGW) ret_finalize_row(C, l, r);
#ifdef NAIVE_MOBA
    for (int u = gw; u < MTOK * 8; u += NGW) { const int h = u & 7, row = u >> 3; moba_naive_query(C, row >> 12, h, row & (SEQ - 1)); }
#endif
}
__device__ __forceinline__ void phase_fixup(const Ctx& C, int l) {
    const float* head = (const float*)(C.ws + WS_HT); const float* tail = head + (size_t)64 * 2 * FF2;
    bf16_t* ACT = (bf16_t*)(C.ws + WS_D);
    const float* cw = C.ka->in[21] + (size_t)l * 3 * FF2; const float* cb = C.ka->in[22] + (size_t)l * FF2;
    const int gt = C.blk * NTHREADS + C.tid, NGT = C.G * NTHREADS;
    for (int idx = gt; idx < 64 * FFH; idx += NGT) {
        const int pm = idx / FFH, jh = idx - pm * FFH;
        if ((pm & 15) == 0) continue;
        const int pn = jh >> 7, col = jh & 127;
        float o0[2], o1[2];
#pragma unroll
        for (int hf = 0; hf < 2; ++hf) {
            const int tc = pn * 256 + hf * 128 + col, wcn = hf * FFH + jh;
            const float hm2 = tail[(size_t)((pm - 1) * 2 + 0) * FF2 + tc], hm1 = tail[(size_t)((pm - 1) * 2 + 1) * FF2 + tc];
            const float h0 = head[(size_t)(pm * 2 + 0) * FF2 + tc], h1 = head[(size_t)(pm * 2 + 1) * FF2 + tc];
            const float w0 = cw[wcn], w1 = cw[FF2 + wcn], w2 = cw[2 * FF2 + wcn], bb = cb[wcn];
            o0[hf] = bb + w0 * hm2 + w1 * hm1 + w2 * h0; o1[hf] = bb + w0 * hm1 + w1 * h0 + w2 * h1;
        }
        ACT[(size_t)(pm * 256 + 0) * FFH + jh] = f2bf(siluf_(o0[0]) * o0[1]);
        ACT[(size_t)(pm * 256 + 1) * FFH + jh] = f2bf(siluf_(o1[0]) * o1[1]);
    }
}

namespace attn_body {
using bf16=unsigned short;
using bf16x8=__attribute__((ext_vector_type(8)))short;
using s16x4=__attribute__((ext_vector_type(4)))short;
using f32x16=__attribute__((ext_vector_type(16)))float;
using u32x4=__attribute__((ext_vector_type(4)))unsigned;
constexpr int BATCH=4,NHEAD=8,SEQ=4096,D=64,PQ=3584,PO=1536;
constexpr int NW=8,QBLK=32,QB=QBLK*NW,KVBLK=64,NQB=SEQ/QB;
constexpr int ATTN_UNIT_ROWS=QB;
__device__ __forceinline__ int crow(int r,int hi){return (r&3)+8*(r>>2)+4*hi;}
#define SBAR() __builtin_amdgcn_sched_barrier(0)
__device__ __forceinline__ void cmask(f32x16&p0,f32x16&p1,int jb,int qrel,int hi){
  const float NEG=-INFINITY; int kb=64*jb+4*hi;
  #pragma unroll
  for(int r=0;r<16;++r){int kv=kb+(r&3)+8*(r>>2); if(kv>qrel)p0[r]=NEG; if(kv+32>qrel)p1[r]=NEG;}
}

constexpr int NSLOT=3, SLOTB=8192;
constexpr int LDS_K=0, LDS_V=NSLOT*SLOTB, LDS_WS=2*NSLOT*SLOTB, LDS_OST=LDS_WS+NW*64*4, LDS_BYTES=LDS_OST+NW*4096;
constexpr float C2=0.125f*1.4426950408889634f;
__device__ __forceinline__ void glds16(const void*gsrc,unsigned lds_dst){unsigned keep;
  asm volatile("s_mov_b32 %0, m0\n\ts_mov_b32 m0, %2\n\ts_nop 0\n\tglobal_load_lds_dwordx4 %1, off\n\ts_mov_b32 m0, %0":"=&s"(keep):"v"(gsrc),"s"(lds_dst):"memory");}
__device__ __forceinline__ float max3f(float a,float b,float c){float r;asm("v_max3_f32 %0, %1, %2, %3":"=v"(r):"v"(a),"v"(b),"v"(c));return r;}
__device__ __forceinline__ float max2f(float a,float b){float r;asm("v_max_f32_e32 %0, %1, %2":"=v"(r):"v"(a),"v"(b));return r;}
__device__ __forceinline__ float fadd_s(float a,float b){float r;asm("v_add_f32_e32 %0, %1, %2":"=v"(r):"v"(a),"v"(b));return r;}
__device__ __forceinline__ float fsub_s(float a,float b){float r;asm("v_sub_f32_e32 %0, %1, %2":"=v"(r):"v"(a),"v"(b));return r;}
typedef float f32x2_t __attribute__((ext_vector_type(2))); typedef __bf16 bf16x2_t __attribute__((ext_vector_type(2)));
__device__ __forceinline__ unsigned cvtpk_s(float lo,float hi){f32x2_t v={lo,hi};bf16x2_t b=__builtin_convertvector(v,bf16x2_t);return __builtin_bit_cast(unsigned,b);}
#define WAIT_BAR(N) asm volatile("s_waitcnt vmcnt(" #N ") lgkmcnt(0)\n\ts_barrier":::"memory")

__device__ __forceinline__ void qkt(f32x16&p0,f32x16&p1,const char*Kslot,const bf16x8*qr,const f32x16&negm,int r32,int hi){
  const char*kb=Kslot+hi*1024+r32*16;
  #pragma unroll
  for(int d0=0;d0<4;++d0){
    const bf16x8 b0=*reinterpret_cast<const bf16x8*>(kb+d0*2048);
    const bf16x8 b1=*reinterpret_cast<const bf16x8*>(kb+d0*2048+512);
    if(d0==0){p0=__builtin_amdgcn_mfma_f32_32x32x16_bf16(b0,qr[0],negm,0,0,0);p1=__builtin_amdgcn_mfma_f32_32x32x16_bf16(b1,qr[0],negm,0,0,0);}
    else{p0=__builtin_amdgcn_mfma_f32_32x32x16_bf16(b0,qr[d0],p0,0,0,0);p1=__builtin_amdgcn_mfma_f32_32x32x16_bf16(b1,qr[d0],p1,0,0,0);}}
}
typedef __attribute__((address_space(3))) const char* lds_cptr;
typedef short v4i16_t __attribute__((ext_vector_type(4)));
__device__ __forceinline__ void kload8(bf16x8*kf,lds_cptr kp){
  kf[0]=*(const __attribute__((address_space(3))) bf16x8*)(kp);      kf[1]=*(const __attribute__((address_space(3))) bf16x8*)(kp+512);
  kf[2]=*(const __attribute__((address_space(3))) bf16x8*)(kp+2048); kf[3]=*(const __attribute__((address_space(3))) bf16x8*)(kp+2560);
  kf[4]=*(const __attribute__((address_space(3))) bf16x8*)(kp+4096); kf[5]=*(const __attribute__((address_space(3))) bf16x8*)(kp+4608);
  kf[6]=*(const __attribute__((address_space(3))) bf16x8*)(kp+6144); kf[7]=*(const __attribute__((address_space(3))) bf16x8*)(kp+6656);
}
__device__ __forceinline__ void kload2(bf16x8*kf,lds_cptr kp,int j){ kf[2*j]=*(const __attribute__((address_space(3))) bf16x8*)(kp+j*2048); kf[2*j+1]=*(const __attribute__((address_space(3))) bf16x8*)(kp+j*2048+512); }
__device__ __forceinline__ s16x4 vtr(lds_cptr p){ return __builtin_bit_cast(s16x4,__builtin_amdgcn_ds_read_tr16_b64_v4i16((__attribute__((address_space(3))) v4i16_t*)p)); }
__device__ __forceinline__ float rowmax(const f32x16&p0,const f32x16&p1){
  float a=max3f(p0[0],p0[1],p1[0]),b=max3f(p0[2],p0[3],p1[1]);a=max3f(a,p1[2],p1[3]);
  #pragma unroll
  for(int r=4;r<16;r+=4){a=max3f(a,p0[r],p0[r+1]);b=max3f(b,p0[r+2],p0[r+3]);a=max3f(a,p1[r],p1[r+1]);b=max3f(b,p1[r+2],p1[r+3]);}
  const float m=max2f(a,b);
  auto rr=__builtin_amdgcn_permlane32_swap(__float_as_uint(m),__float_as_uint(m),false,false);
  return max2f(__uint_as_float(rr[0]),__uint_as_float(rr[1]));
}
__device__ __forceinline__ void pv(f32x16*o,int vb,bf16x8 pa0,bf16x8 pa1,bf16x8 pa2,bf16x8 pa3){
  #pragma unroll
  for(int d0=0;d0<2;++d0){s16x4 lo[4],hi[4];
    #pragma unroll
    for(int ks=0;ks<4;++ks){
      asm volatile("ds_read_b64_tr_b16 %0,%1 offset:%c2":"=&v"(lo[ks]):"v"(vb),"i"(d0*4096+ks*1024):"memory");
      asm volatile("ds_read_b64_tr_b16 %0,%1 offset:%c2":"=&v"(hi[ks]):"v"(vb),"i"(d0*4096+ks*1024+512):"memory");}
    asm volatile("s_waitcnt lgkmcnt(0)":::"memory");SBAR();
    #define PK(k) (bf16x8){lo[k][0],lo[k][1],lo[k][2],lo[k][3],hi[k][0],hi[k][1],hi[k][2],hi[k][3]}
    o[d0]=__builtin_amdgcn_mfma_f32_32x32x16_bf16(pa0,PK(0),o[d0],0,0,0);
    o[d0]=__builtin_amdgcn_mfma_f32_32x32x16_bf16(pa1,PK(1),o[d0],0,0,0);
    o[d0]=__builtin_amdgcn_mfma_f32_32x32x16_bf16(pa2,PK(2),o[d0],0,0,0);
    o[d0]=__builtin_amdgcn_mfma_f32_32x32x16_bf16(pa3,PK(3),o[d0],0,0,0);
    #undef PK
  }
}

#ifndef ATTN_STORE16
#define ATTN_STORE16(p,v) (*(u32x4*)(p)=(v))
#endif
template<int THRL> __device__ __forceinline__ void attn_unit(int tid,int b,int h,int qb,const bf16*Q,const bf16* K,const bf16* V,bf16*O,const unsigned short*SEL,char*shm,int dry){
  const int lane=tid&63,r32=lane&31,hi=lane>>5; const int wid=__builtin_amdgcn_readfirstlane(tid>>6);
  const long rowbase=(long)b*SEQ; const int q0=qb*QB;
  const bf16*Qw=Q+(rowbase+q0+wid*QBLK)*PQ+h*D;
  const bf16*Kh=K+rowbase*PQ+h*D,*Vh=V+rowbase*PQ+h*D;
  const unsigned lds0=(unsigned)(uintptr_t)shm;
  float*wsf=(float*)(shm+LDS_WS)+wid*64;
  const bf16*ksrc=Kh+(long)lane*PQ+wid*8;
  const bf16*vsrc=Vh+(long)(16*(wid&3)+(lane>>2))*PQ+(wid>>2)*32+(lane&3)*8;
  const unsigned kdst=lds0+LDS_K+wid*1024, vdst=lds0+LDS_V+wid*1024;
  #define DMA_K(t,slot) glds16(ksrc+(long)(t)*KVBLK*PQ,(unsigned)__builtin_amdgcn_readfirstlane(kdst+(slot)))
  #define DMA_V(t,slot) glds16(vsrc+(long)(t)*KVBLK*PQ,(unsigned)__builtin_amdgcn_readfirstlane(vdst+(slot)))
  const int vb0=(int)(lds0+LDS_V)+((lane>>4)&1)*32+(lane&3)*8+(4*hi+((lane&15)>>2))*64;
  const char*Kbase=shm+LDS_K; bf16x8 kf[8];
  const lds_cptr shm3=(lds_cptr)shm; const lds_cptr kp0=shm3+LDS_K+hi*1024+r32*16; const lds_cptr vp0=shm3+LDS_V+((lane>>4)&1)*32+(lane&3)*8+(4*hi+((lane&15)>>2))*64;
  const int NT=(dry&2)?4:(q0+QB)/KVBLK;
  DMA_K(0,0);DMA_V(0,0);DMA_K(1,SLOTB);
  bf16x8 qr[4];
  #pragma unroll
  for(int d0=0;d0<4;++d0)qr[d0]=*reinterpret_cast<const bf16x8*>(&Qw[(long)r32*PQ+d0*16+hi*8]);
  #define QRD(k) qr[k]
  float l_reg=0.f;f32x16 o[2];o[0]=f32x16{};o[1]=f32x16{};const f32x16 negm=f32x16{};
  const int qrel=wid*QBLK+r32;
  const unsigned selm=SEL[((long)(b*NHEAD+h))*SEQ+q0+qrel];
  #define SELM(P0,P1,t) do{ if(!(dry&4)&&!((selm>>((t)>>2))&1u)){ _Pragma("unroll") for(int r=0;r<16;++r){P0[r]=-INFINITY;P1[r]=-INFINITY;} } }while(0)
  #define CMASK(P0,P1,t) do{int jb_=(t)-(NT-4); if(jb_>=0)cmask(P0,P1,jb_,qrel,hi);}while(0)
  bool resc=false;
  #define START(P0,P1) do{ resc=false; \
    _Pragma("unroll") for(int r=0;r<16;++r)P0[r]=__builtin_amdgcn_exp2f(P0[r]); }while(0)
  #define RESC() do{ if(resc){ asm volatile("s_waitcnt lgkmcnt(0)":::"memory"); \
      _Pragma("unroll") for(int d_=0;d_<2;++d_) _Pragma("unroll") for(int r=0;r<16;++r)o[d_][r]*=wsf[crow(r,hi)]; } }while(0)
  f32x16 pA0,pA1,pB0,pB1;
  int sl_prev=0,sl_cur=0,sl_next=SLOTB;
  #define ROT() do{sl_prev=sl_cur;sl_cur=sl_next;sl_next=(sl_next==(NSLOT-1)*SLOTB)?0:sl_next+SLOTB;}while(0)
  DMA_K(2,2*SLOTB);
  WAIT_BAR(3);
  qkt(pA0,pA1,Kbase,qr,negm,r32,hi);asm volatile("s_nop 15\n\ts_nop 7":"+v"(pA0),"+v"(pA1));CMASK(pA0,pA1,0);SELM(pA0,pA1,0);
  START(pA0,pA1);
  _Pragma("unroll") for(int r=0;r<16;++r)pA1[r]=__builtin_amdgcn_exp2f(pA1[r]);
  WAIT_BAR(0);
  DMA_K(3,0);DMA_V(1,SLOTB);
  ROT();
  kload8(kf,kp0+sl_cur);
  WAIT_BAR(2);
  s16x4 vlo[8],vhi[8]; u32x4 pw0,pw1,pw2,pw3;
  #define PKW(P,B) cvtpk_s(P[B],P[B+1])
  #define PAF(k) __builtin_bit_cast(bf16x8,pw##k)
  #define VFR(i) (bf16x8){vlo[i][0],vlo[i][1],vlo[i][2],vlo[i][3],vhi[i][0],vhi[i][1],vhi[i][2],vhi[i][3]}
  #define PIN(x) asm volatile("":"+v"(x))
  #define MX3(a,b,c) __builtin_fmaxf(__builtin_fmaxf((a),(b)),(c))
  #define GAPA(MF,A0,A1,A2,A3,W0,W1,PW) do{ MF; sacc+=A0; sacc+=A1; sacc+=A2; sacc+=A3; PIN(sacc); W0; W1; PIN(PW); SBAR(); }while(0)
  #define EX(v) __builtin_amdgcn_exp2f(v)
  #define GAPB(MF,X,B) do{ MF; X[B]=EX(X[B]); X[B+1]=EX(X[B+1]); X[B+2]=EX(X[B+2]); X[B+3]=EX(X[B+3]); PIN(X); SBAR(); }while(0)
  #define VRD(i) do{ vlo[i]=vtr(vp_+(((i)>>2)*4096+((i)&3)*1024)); vhi[i]=vtr(vp_+(((i)>>2)*4096+((i)&3)*1024+512)); }while(0)
  #define KRD(G,j) do{ if(G){ kload2(kf,kp0+sl_next,j); SBAR(); } }while(0)
  #define STEP(C0,C1,P0,P1,t,GK,GV,GL) do{ SBAR(); \
    const lds_cptr vp_=vp0+sl_prev; \
    VRD(0); SBAR(); float sacc=(P0[0]+P0[1]); \
    GAPA(C0=__builtin_amdgcn_mfma_f32_32x32x16_bf16(kf[0],QRD(0),negm,0,0,0), P0[2],P0[3],P0[4],P0[5],     pw0[0]=PKW(P0,0), pw0[1]=PKW(P0,2), pw0); \
    VRD(4); SBAR(); GAPA(C1=__builtin_amdgcn_mfma_f32_32x32x16_bf16(kf[1],QRD(0),negm,0,0,0), P0[6],P0[7],P0[8],P0[9],     pw0[2]=PKW(P0,4), pw0[3]=PKW(P0,6), pw0); \
    VRD(1); SBAR(); GAPA(C0=__builtin_amdgcn_mfma_f32_32x32x16_bf16(kf[2],QRD(1),C0,0,0,0),   P0[10],P0[11],P0[12],P0[13], pw1[0]=PKW(P0,8), pw1[1]=PKW(P0,10), pw1); \
    VRD(5); SBAR(); GAPA(C1=__builtin_amdgcn_mfma_f32_32x32x16_bf16(kf[3],QRD(1),C1,0,0,0),   P0[14],P0[15],P1[0],P1[1],   pw1[2]=PKW(P0,12),pw1[3]=PKW(P0,14), pw1); \
    VRD(2); SBAR(); GAPA(C0=__builtin_amdgcn_mfma_f32_32x32x16_bf16(kf[4],QRD(2),C0,0,0,0),   P1[2],P1[3],P1[4],P1[5],     pw2[0]=PKW(P1,0), pw2[1]=PKW(P1,2), pw2); \
    VRD(6); SBAR(); GAPA(C1=__builtin_amdgcn_mfma_f32_32x32x16_bf16(kf[5],QRD(2),C1,0,0,0),   P1[6],P1[7],P1[8],P1[9],     pw2[2]=PKW(P1,4), pw2[3]=PKW(P1,6), pw2); \
    VRD(3); SBAR(); GAPA(C0=__builtin_amdgcn_mfma_f32_32x32x16_bf16(kf[6],QRD(3),C0,0,0,0),   P1[10],P1[11],P1[12],P1[13], pw3[0]=PKW(P1,8), pw3[1]=PKW(P1,10), pw3); \
    VRD(7); SBAR(); GAPA(C1=__builtin_amdgcn_mfma_f32_32x32x16_bf16(kf[7],QRD(3),C1,0,0,0),   P1[14],P1[15],0.f,0.f,       pw3[2]=PKW(P1,12),pw3[3]=PKW(P1,14), pw3); \
    l_reg+=sacc; \
    if(GK){DMA_K((t)+3,sl_cur);} if(GV){DMA_V((t)+1,sl_next);} \
    CMASK(C0,C1,t); SELM(C0,C1,t); \
      \
    SBAR(); \
    GAPB(o[0]=__builtin_amdgcn_mfma_f32_32x32x16_bf16(PAF(0),VFR(0),o[0],0,0,0), C0,0); \
    GAPB(o[1]=__builtin_amdgcn_mfma_f32_32x32x16_bf16(PAF(0),VFR(4),o[1],0,0,0), C0,4); \
    KRD(GL,0); GAPB(o[0]=__builtin_amdgcn_mfma_f32_32x32x16_bf16(PAF(1),VFR(1),o[0],0,0,0), C0,8); \
    KRD(GL,1); GAPB(o[1]=__builtin_amdgcn_mfma_f32_32x32x16_bf16(PAF(1),VFR(5),o[1],0,0,0), C0,12); \
    KRD(GL,2); GAPB(o[0]=__builtin_amdgcn_mfma_f32_32x32x16_bf16(PAF(2),VFR(2),o[0],0,0,0), C1,0); \
    KRD(GL,3); GAPB(o[1]=__builtin_amdgcn_mfma_f32_32x32x16_bf16(PAF(2),VFR(6),o[1],0,0,0), C1,4); \
    GAPB(o[0]=__builtin_amdgcn_mfma_f32_32x32x16_bf16(PAF(3),VFR(3),o[0],0,0,0), C1,8); \
    GAPB(o[1]=__builtin_amdgcn_mfma_f32_32x32x16_bf16(PAF(3),VFR(7),o[1],0,0,0), C1,12); \
    }while(0)
  int t=1;
  #undef CMASK
  #define CMASK(P0,P1,t) do{}while(0)
  for(;t+5<NT;t+=2){
    STEP(pB0,pB1,pA0,pA1,t,true,true,true);     WAIT_BAR(2); RESC(); ROT();
    STEP(pA0,pA1,pB0,pB1,t+1,true,true,true);   WAIT_BAR(2); RESC(); ROT();
  }
  #undef CMASK
  #define CMASK(P0,P1,t) do{int jb_=(t)-(NT-4); if(jb_>=0)cmask(P0,P1,jb_,qrel,hi);}while(0)
  #define ENDW(tt) do{ if((tt)+3<NT){WAIT_BAR(2);} else if((tt)+2<NT){WAIT_BAR(1);} else {WAIT_BAR(0);} }while(0)
  for(;t+1<NT;t+=2){
    STEP(pB0,pB1,pA0,pA1,t,(t+3<NT),(t+1<NT),(t+1<NT));       ENDW(t);   RESC(); ROT();
    STEP(pA0,pA1,pB0,pB1,t+1,(t+4<NT),(t+2<NT),(t+2<NT));     ENDW(t+1); RESC(); ROT();
  }
  STEP(pB0,pB1,pA0,pA1,NT-1,false,false,false); RESC();
  { float sacc=pB0[0]+pB0[1]; _Pragma("unroll") for(int r=2;r<16;++r)sacc+=pB0[r]; _Pragma("unroll") for(int r=0;r<16;++r)sacc+=pB1[r]; l_reg+=sacc;
    pw0=(u32x4){PKW(pB0,0),PKW(pB0,2),PKW(pB0,4),PKW(pB0,6)};pw1=(u32x4){PKW(pB0,8),PKW(pB0,10),PKW(pB0,12),PKW(pB0,14)};pw2=(u32x4){PKW(pB1,0),PKW(pB1,2),PKW(pB1,4),PKW(pB1,6)};pw3=(u32x4){PKW(pB1,8),PKW(pB1,10),PKW(pB1,12),PKW(pB1,14)};
    SBAR(); pv(o,vb0+sl_cur,PAF(0),PAF(1),PAF(2),PAF(3)); }
  #undef PKW
  #undef PAF
  #undef VFR
  #undef PIN
  #undef MX3
  #undef GAPA
  #undef GAPB
  #undef EX
  #undef VRD
  #undef KRD
  #undef STEP
  #undef ENDW
  {auto rr=__builtin_amdgcn_permlane32_swap(__float_as_uint(l_reg),__float_as_uint(l_reg),false,false);l_reg=__uint_as_float(rr[0])+__uint_as_float(rr[1]);}
  if(hi==0)wsf[32+r32]=l_reg;asm volatile("s_waitcnt lgkmcnt(0)":::"memory");
  float rli[16];
  #pragma unroll
  for(int r=0;r<16;++r)rli[r]=__builtin_amdgcn_rcpf(wsf[32+crow(r,hi)]);
  bf16*Ow=O+(rowbase+q0+wid*QBLK)*PO+h*D;
  { bf16*stg=(bf16*)(shm+LDS_OST)+wid*2048;
    #pragma unroll
    for(int r=0;r<16;++r){const int orow=crow(r,hi);
      #pragma unroll
      for(int d0=0;d0<2;++d0)stg[orow*64+d0*32+r32]=f2bf(o[d0][r]*rli[r]);}
    asm volatile("s_waitcnt lgkmcnt(0)":::"memory");
    #pragma unroll
    for(int i=0;i<4;++i){const int row=i*8+(lane>>3),ch=lane&7; const u32x4 v=*(const u32x4*)(stg+row*64+ch*8); if(!dry)ATTN_STORE16(Ow+(long)row*PO+ch*8,v);} }
  asm volatile("s_waitcnt lgkmcnt(0)\n\ts_barrier":::"memory");
  #undef QRD
  #undef SELM
  #undef DMA_K
  #undef DMA_V
  #undef CMASK
  #undef START
  #undef RESC
  #undef ROT
}
constexpr int ATTN_LDS_BYTES=LDS_BYTES;
struct AttnTensors { const bf16* Q; const bf16* K; const bf16* V; bf16* O; const unsigned short* SEL; int dry; };
struct AttnUnit { int bh; int qb; };
struct StaticOrder {
  int vcu;
  __device__ __forceinline__ explicit StaticOrder(int grid,int block):vcu((grid%8==0)?(block%8)*(grid/8)+block/8:block),G(grid){}
  int G;
  __device__ __forceinline__ bool next(int i,AttnUnit&u)const{ const int v=vcu+(i>>1)*G; if(v>=256)return false; const int s=v&7; u.bh=v>>3; u.qb=(i&1)?s:15-s; return true; }
};
template<class Sched,int THRL=8> __device__ __forceinline__ void attn_phase(int tid,char*lds,const AttnTensors&T,const Sched&S){
  AttnUnit u;
  for(int i=0;S.next(i,u);++i){ attn_unit<THRL>(tid,u.bh/NHEAD,u.bh%NHEAD,u.qb,T.Q,T.K,T.V,T.O,T.SEL,lds,T.dry); }
}
#undef SBAR
#undef WAIT_BAR
}

constexpr size_t WS_SEL = 640 * 1024;
__device__ __forceinline__ void select_unit(const Ctx& C, int u) {
    const bf16_t* P = (const bf16_t*)(C.ws + WS_D); const float* KM = (const float*)(C.ws + WS_KMEAN); unsigned short* SEL = (unsigned short*)(C.ws + WS_SEL);
    const int lane = (C.tid & 63), w = __builtin_amdgcn_readfirstlane(C.tid >> 6), g = lane >> 4, i = lane & 15;
    LAS unsigned char* sc = C.lds + w * 5120;
    const int bh = u >> 3, ch = u & 7, b = bh >> 3, h = bh & 7;
    const int t0 = ch * 512 + 64 * w, qblk = t0 >> 8;
    bf16x8 ah[2], al[2];
#pragma unroll
    for (int ks = 0; ks < 2; ++ks) {
        const float* kp = KM + bh * 1024 + i * 64 + 32 * ks + 8 * g;
        const f32x4 x0 = *(const f32x4*)kp, x1 = *(const f32x4*)(kp + 4);
        u32x4 ph, pl;
        ph.x = cvt_pk_bf16(x0.x, x0.y); pl.x = cvt_pk_bf16(x0.x - bflo(ph.x), x0.y - bfhi(ph.x));
        ph.y = cvt_pk_bf16(x0.z, x0.w); pl.y = cvt_pk_bf16(x0.z - bflo(ph.y), x0.w - bfhi(ph.y));
        ph.z = cvt_pk_bf16(x1.x, x1.y); pl.z = cvt_pk_bf16(x1.x - bflo(ph.z), x1.y - bfhi(ph.z));
        ph.w = cvt_pk_bf16(x1.z, x1.w); pl.w = cvt_pk_bf16(x1.z - bflo(ph.w), x1.w - bfhi(ph.w));
        ah[ks] = (bf16x8)ph; al[ks] = (bf16x8)pl;
    }
#pragma unroll
    for (int tt = 0; tt < 4; ++tt) {
        const bf16_t* qp = P + (size_t)(b * SEQ + t0 + 16 * tt + i) * NNG + C_QA + h * 64 + 8 * g;
        const bf16x8 q0 = *(const bf16x8*)qp, q1 = *(const bf16x8*)(qp + 32);
        f32x4 acc = (f32x4){0.f, 0.f, 0.f, 0.f};
        acc = __builtin_amdgcn_mfma_f32_16x16x32_bf16(ah[0], q0, acc, 0, 0, 0);
        acc = __builtin_amdgcn_mfma_f32_16x16x32_bf16(al[0], q0, acc, 0, 0, 0);
        acc = __builtin_amdgcn_mfma_f32_16x16x32_bf16(ah[1], q1, acc, 0, 0, 0);
        acc = __builtin_amdgcn_mfma_f32_16x16x32_bf16(al[1], q1, acc, 0, 0, 0);
        *(LAS f32x4*)(sc + (16 * tt + i) * 80 + g * 16) = acc;
    }
    asm volatile("s_waitcnt lgkmcnt(0)" ::: "memory");
    const f32x4 s0 = *(const LAS f32x4*)(sc + lane * 80), s1 = *(const LAS f32x4*)(sc + lane * 80 + 16), s2 = *(const LAS f32x4*)(sc + lane * 80 + 32), s3 = *(const LAS f32x4*)(sc + lane * 80 + 48);
    float v1 = -INFINITY, v2 = -INFINITY, v3 = -INFINITY; int i1 = -1, i2 = -1, i3 = -1;
#define SEL_INS(G_, J_) if ((J_) < qblk) { const float gq = (G_); \
        if (gq > v1) { v3 = v2; i3 = i2; v2 = v1; i2 = i1; v1 = gq; i1 = (J_); } \
        else if (gq > v2) { v3 = v2; i3 = i2; v2 = gq; i2 = (J_); } \
        else if (gq > v3) { v3 = gq; i3 = (J_); } }
    SEL_INS(s0.x, 0) SEL_INS(s0.y, 1) SEL_INS(s0.z, 2) SEL_INS(s0.w, 3)
    SEL_INS(s1.x, 4) SEL_INS(s1.y, 5) SEL_INS(s1.z, 6) SEL_INS(s1.w, 7)
    SEL_INS(s2.x, 8) SEL_INS(s2.y, 9) SEL_INS(s2.z, 10) SEL_INS(s2.w, 11)
    SEL_INS(s3.x, 12) SEL_INS(s3.y, 13) SEL_INS(s3.z, 14)
#undef SEL_INS
    unsigned m = 1u << qblk;
    if (i1 >= 0) m |= 1u << i1;
    if (i2 >= 0) m |= 1u << i2;
    if (i3 >= 0) m |= 1u << i3;
    SEL[(size_t)bh * SEQ + t0 + lane] = (unsigned short)m;
}
__device__ __forceinline__ void phase_select(const Ctx& C) {
    for (int u = C.blk; u < 256; u += C.G) select_unit(C, u);
}


constexpr size_t WS_KVS = WS_G + 17 * MiB;
typedef short v4i16_t __attribute__((ext_vector_type(4)));
__device__ __forceinline__ v4i16_t lds_tr16(LAS unsigned char* p) { return __builtin_amdgcn_ds_read_tr16_b64_v4i16((LAS v4i16_t*)p); }
__device__ __forceinline__ bf16x8 cat44(v4i16_t a, v4i16_t b) { return (bf16x8){a[0], a[1], a[2], a[3], b[0], b[1], b[2], b[3]}; }

__device__ __forceinline__ void ret_kv_unit(const Ctx& C, int bh, int n) {
    const int tid = C.tid, lane = (C.tid & 63), w = __builtin_amdgcn_readfirstlane(C.tid >> 6), g = lane >> 4, i = lane & 15;
    const int b = bh >> 2, h = bh & 3;
    const bf16_t* P = (const bf16_t*)(C.ws + WS_D) + (size_t)(b * SEQ + n * 128) * NNG;
    LAS unsigned char* Kimg = C.lds; LAS unsigned char* Vimg = C.lds + 16384;
    const float lg2 = log2f(1.f - exp2f(-5.f - (float)h));
    __syncthreads();
#pragma unroll
    for (int r = 0; r < 2; ++r) { const int id = tid + 512 * r, m = id >> 3, ch = id & 7;
        *(LAS u32x4*)(Kimg + m * 128 + ch * 16) = *(const u32x4*)(P + (size_t)m * NNG + C_KR + h * 64 + 8 * ch); }
#pragma unroll
    for (int r = 0; r < 4; ++r) { const int id = tid + 512 * r, m = id >> 4, ch = id & 15;
        const u32x4 v = *(const u32x4*)(P + (size_t)m * NNG + C_VR + h * 128 + 8 * ch);
        const float z = exp2f(lg2 * (float)(127 - m));
        u32x4 o; o.x = cvt_pk_bf16(bflo(v.x) * z, bfhi(v.x) * z); o.y = cvt_pk_bf16(bflo(v.y) * z, bfhi(v.y) * z); o.z = cvt_pk_bf16(bflo(v.z) * z, bfhi(v.z) * z); o.w = cvt_pk_bf16(bflo(v.w) * z, bfhi(v.w) * z);
        *(LAS u32x4*)(Vimg + m * 256 + ch * 16) = o; }
    __syncthreads();
    f32x4 acc[4];
#pragma unroll
    for (int dt = 0; dt < 4; ++dt) acc[dt] = (f32x4){0.f, 0.f, 0.f, 0.f};
    const int e0 = 16 * w;
#pragma unroll
    for (int ks = 0; ks < 4; ++ks) {
        const int mr = 32 * ks + 8 * g + (i >> 2);
        const bf16x8 A = cat44(lds_tr16(Vimg + mr * 256 + (e0 + 4 * (i & 3)) * 2), lds_tr16(Vimg + (mr + 4) * 256 + (e0 + 4 * (i & 3)) * 2));
#pragma unroll
        for (int dt = 0; dt < 4; ++dt) {
            const bf16x8 B = cat44(lds_tr16(Kimg + mr * 128 + (16 * dt + 4 * (i & 3)) * 2), lds_tr16(Kimg + (mr + 4) * 128 + (16 * dt + 4 * (i & 3)) * 2));
            acc[dt] = __builtin_amdgcn_mfma_f32_16x16x32_bf16(A, B, acc[dt], 0, 0, 0);
        }
    }
    bf16_t* KV = (bf16_t*)(C.ws + WS_KVS) + (size_t)(bh * 32 + n) * 8192;
#pragma unroll
    for (int dt = 0; dt < 4; ++dt)
#pragma unroll
        for (int r = 0; r < 4; ++r) KV[(e0 + 4 * g + r) * 64 + 16 * dt + i] = f2bf(acc[dt][r]);
}
__device__ __forceinline__ void ret_scan(const Ctx& C) {
    const int gt = C.blk * NTHREADS + C.tid, NGT = C.G * NTHREADS;
    for (int idx = gt; idx < 16 * 8192; idx += NGT) {
        const int bh = idx >> 13, el = idx & 8191, h = bh & 3;
        const float cd = exp2f(128.f * log2f(1.f - exp2f(-5.f - (float)h)));
        bf16_t* p = (bf16_t*)(C.ws + WS_KVS) + (size_t)bh * 32 * 8192 + el;
        float v[32];
#pragma unroll
        for (int n = 0; n < 32; ++n) v[n] = bf2f(p[(size_t)n * 8192]);
        float st = 0.f;
#pragma unroll
        for (int n = 0; n < 32; ++n) { p[(size_t)n * 8192] = f2bf(st); st = cd * st + v[n]; }
    }
}
__device__ __forceinline__ void ret_out_unit(const Ctx& C, int l, int bh, int n) {
    const int tid = C.tid, lane = (C.tid & 63), w = __builtin_amdgcn_readfirstlane(C.tid >> 6), g = lane >> 4, i = lane & 15;
    const int b = bh >> 2, h = bh & 3;
    const size_t row0 = (size_t)(b * SEQ + n * 128);
    const bf16_t* P = (const bf16_t*)(C.ws + WS_D) + row0 * NNG;
    LAS unsigned char* Vimg = C.lds; LAS unsigned char* Kimg = C.lds + 36864; LAS unsigned char* Simg = C.lds + 55296;
    const float lg2 = log2f(1.f - exp2f(-5.f - (float)h));
    const bf16_t* ST = (const bf16_t*)(C.ws + WS_KVS) + (size_t)(bh * 32 + n) * 8192;
    const int c = 16 * w + i;
    __syncthreads();
    {
        u32x4 vv[4], kk[2], ss[2];
#pragma unroll
        for (int r = 0; r < 4; ++r) { const int id = tid + 512 * r; vv[r] = *(const u32x4*)(P + (size_t)(id >> 4) * NNG + C_VR + h * 128 + 8 * (id & 15)); }
#pragma unroll
        for (int r = 0; r < 2; ++r) { const int id = tid + 512 * r; kk[r] = *(const u32x4*)(P + (size_t)(id >> 3) * NNG + C_KR + h * 64 + 8 * (id & 7)); ss[r] = *(const u32x4*)(ST + (size_t)id * 8); }
#pragma unroll
        for (int r = 0; r < 4; ++r) { const int id = tid + 512 * r; *(LAS u32x4*)(Vimg + (id >> 4) * 288 + (id & 15) * 16) = vv[r]; }
#pragma unroll
        for (int r = 0; r < 2; ++r) { const int id = tid + 512 * r; *(LAS u32x4*)(Kimg + (id >> 3) * 144 + (id & 7) * 16) = kk[r]; *(LAS u32x4*)(Simg + (id >> 3) * 144 + (id & 7) * 16) = ss[r]; }
    }
    bf16x8 qf[2];
#pragma unroll
    for (int ks = 0; ks < 2; ++ks) qf[ks] = *(const bf16x8*)(P + (size_t)c * NNG + C_QR + h * 64 + 32 * ks + 8 * g);
    const bf16_t* GS = P + (size_t)c * NNG + C_GR + h * 128;
    u32x2 gsv[8];
#pragma unroll
    for (int et = 0; et < 8; ++et) gsv[et] = *(const u32x2*)(GS + 16 * et + 4 * g);
    __syncthreads();
    f32x4 acc[8];
#pragma unroll
    for (int et = 0; et < 8; ++et) {
        acc[et] = (f32x4){0.f, 0.f, 0.f, 0.f};
#pragma unroll
        for (int ks = 0; ks < 2; ++ks) { const bf16x8 A = *(const LAS bf16x8*)(Simg + (16 * et + i) * 144 + (32 * ks + 8 * g) * 2);
            acc[et] = __builtin_amdgcn_mfma_f32_16x16x32_bf16(A, qf[ks], acc[et], 0, 0, 0); }
    }
    const float xi = __builtin_amdgcn_exp2f(lg2 * (float)(c + 1));
#pragma unroll
    for (int et = 0; et < 8; ++et) acc[et] *= xi;
#pragma unroll
    for (int s = 0; s < 4; ++s) {
        if (2 * s <= w) {
            f32x4 st[2];
#pragma unroll
            for (int u = 0; u < 2; ++u) {
                const int mt = 2 * s + u;
                st[u] = (f32x4){0.f, 0.f, 0.f, 0.f};
                if (mt <= w) {
#pragma unroll
                    for (int ks = 0; ks < 2; ++ks) { const bf16x8 Kf = *(const LAS bf16x8*)(Kimg + (16 * mt + i) * 144 + (32 * ks + 8 * g) * 2);
                        st[u] = __builtin_amdgcn_mfma_f32_16x16x32_bf16(Kf, qf[ks], st[u], 0, 0, 0); }
#pragma unroll
                    for (int r = 0; r < 4; ++r) { const int m = 16 * mt + 4 * g + r; st[u][r] = (c >= m) ? st[u][r] * __builtin_amdgcn_exp2f(lg2 * (float)(c - m)) : 0.f; }
                }
            }
            bf16x8 Pf;
            { u32x4 pw; pw.x = cvt_pk_bf16(st[0][0], st[0][1]); pw.y = cvt_pk_bf16(st[0][2], st[0][3]); pw.z = cvt_pk_bf16(st[1][0], st[1][1]); pw.w = cvt_pk_bf16(st[1][2], st[1][3]); Pf = __builtin_bit_cast(bf16x8, pw); }
            const int mr = 32 * s + 4 * g + (i >> 2);
#pragma unroll
            for (int et = 0; et < 8; ++et) {
                const bf16x8 A = cat44(lds_tr16(Vimg + mr * 288 + (16 * et + 4 * (i & 3)) * 2), lds_tr16(Vimg + (mr + 16) * 288 + (16 * et + 4 * (i & 3)) * 2));
                acc[et] = __builtin_amdgcn_mfma_f32_16x16x32_bf16(A, Pf, acc[et], 0, 0, 0);
            }
        }
    }
    float sm = 0.f;
#pragma unroll
    for (int et = 0; et < 8; ++et) sm += (acc[et][0] + acc[et][1]) + (acc[et][2] + acc[et][3]);
    sm += shx(sm, 16, lane); sm += shx(sm, 32, lane);
    const float mu = sm * (1.0f / 128.0f); float q2 = 0.f;
#pragma unroll
    for (int et = 0; et < 8; ++et) { acc[et] -= mu; q2 += (acc[et][0] * acc[et][0] + acc[et][1] * acc[et][1]) + (acc[et][2] * acc[et][2] + acc[et][3] * acc[et][3]); }
    q2 += shx(q2, 16, lane); q2 += shx(q2, 32, lane);
    const float rs = rsqrtf(q2 * (1.0f / 128.0f) + NORM_EPS);
    const float* gn = C.ka->in[12] + l * 512 + h * 128;
    bf16_t* Y = (bf16_t*)(C.ws + WS_E) + (row0 + c) * 1536 + 512 + h * 128;
#pragma unroll
    for (int et = 0; et < 8; ++et) {
        const int e = 16 * et + 4 * g;
        const u32x2 gs = gsv[et]; const f32x4 gg = *(const f32x4*)(gn + e);
        u32x2 o; o.x = cvt_pk_bf16(bflo(gs.x) * (acc[et][0] * rs * gg.x), bfhi(gs.x) * (acc[et][1] * rs * gg.y));
        o.y = cvt_pk_bf16(bflo(gs.y) * (acc[et][2] * rs * gg.z), bfhi(gs.y) * (acc[et][3] * rs * gg.w));
        *(u32x2*)(Y + e) = o;
    }
}


constexpr size_t WS_S5_BT2 = 212 * MiB;
constexpr size_t WS_S5_BT1 = 232 * MiB;
constexpr size_t WS_S5_SN = 237 * MiB;
constexpr size_t WS_S5_SP = 241 * MiB;
__device__ __forceinline__ void s5_gen_unit(const Ctx& C, int l, int g, int dp) {
    const int tid = C.tid;
    LAS float* wp = (LAS float*)C.lds;
    LAS float* wq = wp + 5 * 64 * 2;
    LAS float* bb = wq + 32 * 8 * 2;
    const float dt = expf(C.ka->in[5][l * 32 + g]);
    const float* LRE = C.ka->in[3] + (l * 32 + g) * 64; const float* LIM = C.ka->in[4] + (l * 32 + g) * 64;
    __syncthreads();
    if (tid < 320) { const int p = tid & 63; const float d = (float)(4 * dp + (tid >> 6));
        const float er = expf(d * LRE[p] * dt); float sn, cs; sincos_red(d * LIM[p] * dt, sn, cs);
        wp[tid * 2] = er * cs; wp[tid * 2 + 1] = er * sn; }
    if (tid < 256) { const int p = 8 * dp + (tid & 7); const float d = (float)(31 - (tid >> 3));
        const float er = expf(d * LRE[p] * dt); float sn, cs; sincos_red(d * LIM[p] * dt, sn, cs);
        wq[tid * 2] = er * cs; wq[tid * 2 + 1] = er * sn; }
    for (int idx = tid; idx < 1024; idx += NTHREADS) { const int p = idx >> 4;
        const float lre = LRE[p], lim = LIM[p];
        const float er = expf(lre * dt); float sn, cs; sincos_red(lim * dt, sn, cs);
        const float nr = er * cs - 1.f, ni = er * sn, den = lre * lre + lim * lim;
        const float cr = (nr * lre + ni * lim) / den, ci = (ni * lre - nr * lim) / den;
        const float br = C.ka->in[6][(size_t)(l * 32 + g) * 1024 + idx], bi = C.ka->in[7][(size_t)(l * 32 + g) * 1024 + idx];
        bb[idx * 2] = cr * br - ci * bi; bb[idx * 2 + 1] = cr * bi + ci * br; }
    __syncthreads();
    bf16_t* BT2 = (bf16_t*)(C.ws + WS_S5_BT2) + (size_t)g * 512 * 640;
    {
        const int lane = (tid & 63), w = __builtin_amdgcn_readfirstlane(tid >> 6), g4 = lane >> 4, i = lane & 15;
        const int dd = w & 3, th = w >> 2, d = 4 * dp + dd;
        const float* CR = C.ka->in[8] + (size_t)(l * 32 + g) * 1024 + i * 64; const float* CI = C.ka->in[9] + (size_t)(l * 32 + g) * 1024 + i * 64;
        f32x4 acc = (f32x4){0.f, 0.f, 0.f, 0.f};
#pragma unroll
        for (int ks = 0; ks < 4; ++ks) {
            const int p0 = 16 * ks + 4 * g4;
            const f32x4 cr4 = *(const f32x4*)(CR + p0), ci4 = *(const f32x4*)(CI + p0);
            u32x4 ah, al, bh, bl, sv;
#pragma unroll
            for (int j = 0; j < 4; ++j) {
                const int p = p0 + j; const float cr = cr4[j], ci = ci4[j];
                const float w0r = wp[(dd * 64 + p) * 2], w0i = wp[(dd * 64 + p) * 2 + 1], w1r = wp[((dd + 1) * 64 + p) * 2], w1i = wp[((dd + 1) * 64 + p) * 2 + 1];
                const float tr = cr * w0r - ci * w0i, ti = cr * w0i + ci * w0r;
                const float nr = cr * w1r - ci * w1i, ni = -(cr * w1i + ci * w1r);
                const float ar = bb[(p * 16 + i) * 2], ai = -bb[(p * 16 + i) * 2 + 1];
                const unsigned th_ = cvt_pk_bf16(tr, ti), ah_ = cvt_pk_bf16(ar, ai);
                bh[j] = th_; bl[j] = cvt_pk_bf16(tr - bflo(th_), ti - bfhi(th_));
                ah[j] = ah_; al[j] = cvt_pk_bf16(ar - bflo(ah_), ai - bfhi(ah_));
                sv[j] = cvt_pk_bf16(nr, ni);
            }
            acc = __builtin_amdgcn_mfma_f32_16x16x32_bf16((bf16x8)ah, (bf16x8)bh, acc, 0, 0, 0);
            acc = __builtin_amdgcn_mfma_f32_16x16x32_bf16((bf16x8)ah, (bf16x8)bl, acc, 0, 0, 0);
            acc = __builtin_amdgcn_mfma_f32_16x16x32_bf16((bf16x8)al, (bf16x8)bh, acc, 0, 0, 0);
            if ((ks & 1) == th) *(u32x4*)(BT2 + (size_t)(d * 16 + i) * 640 + 512 + 2 * p0) = sv;
        }
        u32x2 o; o.x = cvt_pk_bf16(acc[0], acc[1]); o.y = cvt_pk_bf16(acc[2], acc[3]);
        for (int sk = th; sk + d < 32; sk += 2) *(u32x2*)(BT2 + (size_t)((sk + d) * 16 + i) * 640 + sk * 16 + 4 * g4) = o;
    }
    for (int idx = tid; idx < 64 * 64; idx += NTHREADS) {
        const int rl = idx >> 6, ch = idx & 63, row = 64 * dp + rl, t = row >> 4;
        if ((ch >> 1) > t) *(u32x4*)(BT2 + (size_t)row * 640 + ch * 8) = (u32x4){0u, 0u, 0u, 0u};
    }
    bf16_t* BT1 = (bf16_t*)(C.ws + WS_S5_BT1) + (size_t)g * 128 * 512;
    for (int idx = tid; idx < 16 * 64; idx += NTHREADS) {
        const int rr = idx >> 6, row = 16 * dp + rr, ch = idx & 63, p = row >> 1, ri = row & 1, sk = ch >> 1, hf = ch & 1;
        const float wr_ = wq[(sk * 8 + (rr >> 1)) * 2], wi_ = wq[(sk * 8 + (rr >> 1)) * 2 + 1];
        float v[8];
#pragma unroll
        for (int j = 0; j < 8; ++j) { const float br = bb[(p * 16 + 8 * hf + j) * 2], bi = bb[(p * 16 + 8 * hf + j) * 2 + 1];
            v[j] = ri ? (wr_ * bi + wi_ * br) : (wr_ * br - wi_ * bi); }
        u32x4 o; o.x = cvt_pk_bf16(v[0], v[1]); o.y = cvt_pk_bf16(v[2], v[3]); o.z = cvt_pk_bf16(v[4], v[5]); o.w = cvt_pk_bf16(v[6], v[7]);
        *(u32x4*)(BT1 + (size_t)row * 512 + ch * 8) = o;
    }
    if (g == 31 && dp == 7) {
        for (int idx = tid; idx < 128 * 64; idx += NTHREADS) *(u32x4*)(BT1 + (size_t)128 * 512 + idx * 8) = (u32x4){0u, 0u, 0u, 0u};
    }
}
__device__ __forceinline__ void s5_scan_unit(const Ctx& C, int l, int b, int g) {
    const int p = (C.tid & 63);
    const float lre = C.ka->in[3][(l * 32 + g) * 64 + p], lim = C.ka->in[4][(l * 32 + g) * 64 + p], dt = expf(C.ka->in[5][l * 32 + g]);
    const float er = expf(32.f * lre * dt); float sn, cs; sincos_red(32.f * lim * dt, sn, cs);
    const float ar = er * cs, ai = er * sn;
    const unsigned* SN = (const unsigned*)(C.ws + WS_S5_SN) + ((size_t)(b * 128) * 32 + g) * 64 + p;
    unsigned* SP = (unsigned*)(C.ws + WS_S5_SP) + ((size_t)(b * 128) * 32 + g) * 64 + p;
    float sr = 0.f, si = 0.f;
    for (int n0 = 0; n0 < 128; n0 += 16) {
        unsigned v[16];
#pragma unroll
        for (int j = 0; j < 16; ++j) v[j] = SN[(size_t)(n0 + j) * 2048];
#pragma unroll
        for (int j = 0; j < 16; ++j) {
            SP[(size_t)(n0 + j) * 2048] = cvt_pk_bf16(sr, si);
            const float nr = ar * sr - ai * si + bflo(v[j]), ni = ar * si + ai * sr + bfhi(v[j]);
            sr = nr; si = ni;
        }
    }
}

__device__ __forceinline__ void s5_scan_block(const Ctx& C, int l, int b, int g) {
    const int p = (C.tid & 63), w = __builtin_amdgcn_readfirstlane(C.tid >> 6);
    const float lre = C.ka->in[3][(l * 32 + g) * 64 + p], lim = C.ka->in[4][(l * 32 + g) * 64 + p], dt = expf(C.ka->in[5][l * 32 + g]);
    const float er = expf(32.f * lre * dt); float sn, cs; sincos_red(32.f * lim * dt, sn, cs);
    const float ar = er * cs, ai = er * sn;
    const unsigned* SN = (const unsigned*)(C.ws + WS_S5_SN) + ((size_t)(b * 128 + 16 * w) * 32 + g) * 64 + p;
    unsigned* SP = (unsigned*)(C.ws + WS_S5_SP) + ((size_t)(b * 128 + 16 * w) * 32 + g) * 64 + p;
    LAS float* ex = (LAS float*)(C.lds + 49152);
    unsigned v[16];
#pragma unroll
    for (int j = 0; j < 16; ++j) v[j] = SN[(size_t)j * 2048];
    float sr = 0.f, si = 0.f;
#pragma unroll
    for (int j = 0; j < 16; ++j) { const float nr = ar * sr - ai * si + bflo(v[j]), ni = ar * si + ai * sr + bfhi(v[j]); sr = nr; si = ni; }
    ex[(w * 64 + p) * 2] = sr; ex[(w * 64 + p) * 2 + 1] = si;
    float pr = ar, pi = ai;
#pragma unroll
    for (int k = 0; k < 4; ++k) { const float qr = pr * pr - pi * pi, qi = 2.f * pr * pi; pr = qr; pi = qi; }
    __syncthreads();
    sr = 0.f; si = 0.f;
    for (int s = 0; s < w; ++s) { const float e0 = ex[(s * 64 + p) * 2], e1 = ex[(s * 64 + p) * 2 + 1]; const float nr = pr * sr - pi * si + e0, ni = pr * si + pi * sr + e1; sr = nr; si = ni; }
#pragma unroll
    for (int j = 0; j < 16; ++j) {
        SP[(size_t)j * 2048] = cvt_pk_bf16(sr, si);
        const float nr = ar * sr - ai * si + bflo(v[j]), ni = ar * si + ai * sr + bfhi(v[j]);
        sr = nr; si = ni;
    }
}
__device__ __forceinline__ void ret_scan2(const Ctx& C) {
    const int idx = (C.blk - 128) * NTHREADS + C.tid;
    const int bh = idx >> 13, el = idx & 8191, h = bh & 3;
    const float cd = exp2f(128.f * log2f(1.f - exp2f(-5.f - (float)h)));
    bf16_t* p0 = (bf16_t*)(C.ws + WS_KVS) + (size_t)bh * 32 * 8192 + el;
    bf16_t* p1 = p0 + (size_t)8 * 32 * 8192;
    float v0[32], v1[32];
#pragma unroll
    for (int n = 0; n < 32; ++n) { v0[n] = bf2f(p0[(size_t)n * 8192]); v1[n] = bf2f(p1[(size_t)n * 8192]); }
    float s0 = 0.f, s1 = 0.f;
#pragma unroll
    for (int n = 0; n < 32; ++n) { p0[(size_t)n * 8192] = f2bf(s0); p1[(size_t)n * 8192] = f2bf(s1); s0 = cd * s0 + v0[n]; s1 = cd * s1 + v1[n]; }
}

#define XB_IS_T0(b) ((b).w0 == 0 && lane_id_fresh() == 0)
#define XB_TMO      128
#define XB_XCNT(j)  (256  + 64 * (j))
#define XB_XSUB(j)  (1280 + 64 * (j))
#define XB_XGEN(j)  (2304 + 64 * (j))
#define XB_TOP      3328
#define XB_TOPGEN   3392
#define XCD_BAR_WORDS 3456
#define XB_SPIN_CAP (1u << 18)

__device__ __forceinline__ unsigned xb_ld(unsigned* p)              { return __hip_atomic_load(p, __ATOMIC_RELAXED, __HIP_MEMORY_SCOPE_AGENT); }
__device__ __forceinline__ unsigned xb_add(unsigned* p, unsigned v) { return __hip_atomic_fetch_add(p, v, __ATOMIC_RELAXED, __HIP_MEMORY_SCOPE_AGENT); }
__device__ __forceinline__ unsigned xb_xcc_id() { return (unsigned)__builtin_amdgcn_s_getreg((3 << 11) | 20) & 0xFu; }
#define XB_SPIN(cond, bar) do { unsigned _sp = 0; while (cond) { __builtin_amdgcn_s_sleep(1); \
    if ((++_sp & 255u) == 0u) { if (xb_ld(&(bar)[XB_TMO])) break; if (_sp > XB_SPIN_CAP) { atomicAdd(&(bar)[XB_TMO], 1u); break; } } } } while (0)

struct XcdBarrier {
    unsigned* bar; unsigned x; int w0;
    volatile LAS unsigned* st;
};

__device__ __forceinline__ XcdBarrier xcd_barrier_post(unsigned* bar, volatile LAS unsigned* st) {
    XcdBarrier b; b.bar = bar; b.x = xb_xcc_id(); b.st = st; b.w0 = __builtin_amdgcn_readfirstlane(threadIdx.x >> 6);
    if (threadIdx.x == 0) (void)xb_add(&bar[XB_XCNT(b.x)], 1u);
    return b;
}
__device__ __forceinline__ void xcd_barrier_complete(unsigned* bar, unsigned x, unsigned& nloc, unsigned& nx) {
    const unsigned G = gridDim.x * gridDim.y * gridDim.z;
    unsigned sum, cnt, mine, sp = 0u;
    for (;;) {
        sum = 0u; cnt = 0u; mine = 0u;
#pragma unroll
        for (unsigned j = 0; j < 16; ++j) { const unsigned c = xb_ld(&bar[XB_XCNT(j)]); sum += c; cnt += (c > 0u) ? 1u : 0u; mine = (j == x) ? c : mine; }
        if (sum == G) break;
        __builtin_amdgcn_s_sleep(1);
        if ((++sp & 255u) == 0u) { if (xb_ld(&bar[XB_TMO])) break; if (sp > XB_SPIN_CAP) { atomicAdd(&bar[XB_TMO], 1u); break; } }
    }
    nloc = mine > 0u ? mine : 1u; nx = cnt > 0u ? cnt : 1u;
}

__device__ __forceinline__ void xcd_barrier(const XcdBarrier& b) {
    asm volatile("s_waitcnt vmcnt(0)" ::: "memory");
    __syncthreads();
    if (b.w0 == 1) { __builtin_amdgcn_fence(__ATOMIC_ACQUIRE, "agent"); asm volatile("s_waitcnt vmcnt(0)" ::: "memory"); }
    if (XB_IS_T0(b)) {
        unsigned* bar = b.bar;
        __builtin_amdgcn_s_waitcnt(0);
        unsigned nloc = b.st[0], nx = b.st[1];
        if (nloc == 0u) { xcd_barrier_complete(bar, b.x, nloc, nx); b.st[0] = nloc; b.st[1] = nx; }
        const unsigned old = xb_add(&bar[XB_XSUB(b.x)], 1u);
        const unsigned gen = old / nloc;
        if (old + 1u == (gen + 1u) * nloc) {
            __builtin_amdgcn_fence(__ATOMIC_RELEASE, "agent");
            asm volatile("s_waitcnt vmcnt(0)" ::: "memory");
            const unsigned og = xb_add(&bar[XB_TOP], 1u);
            const unsigned tg = og / nx;
            if (og + 1u == (tg + 1u) * nx) xb_add(&bar[XB_TOPGEN], 1u);
            else XB_SPIN(xb_ld(&bar[XB_TOPGEN]) == tg, bar);
            xb_add(&bar[XB_XGEN(b.x)], 1u);
        } else {
            XB_SPIN(xb_ld(&bar[XB_XGEN(b.x)]) == gen, bar);
        }
    }
    WG_BAR();
}

__device__ __forceinline__ void fixup_tile(const Ctx& C, int l, int pm) {
    if ((pm & 15) == 0) return;
    const float* head = (const float*)(C.ws + WS_HT); const float* tail = head + (size_t)64 * 2 * FF2;
    bf16_t* ACT = (bf16_t*)(C.ws + WS_D);
    const float* cw = C.ka->in[21] + (size_t)l * 3 * FF2; const float* cb = C.ka->in[22] + (size_t)l * FF2;
    for (int jh = C.tid; jh < FFH; jh += NTHREADS) {
        const int pn = jh >> 7, col = jh & 127;
        float o0[2], o1[2];
#pragma unroll
        for (int hf = 0; hf < 2; ++hf) {
            const int tc = pn * 256 + hf * 128 + col, wcn = hf * FFH + jh;
            const float hm2 = tail[(size_t)((pm - 1) * 2 + 0) * FF2 + tc], hm1 = tail[(size_t)((pm - 1) * 2 + 1) * FF2 + tc];
            const float h0 = head[(size_t)(pm * 2 + 0) * FF2 + tc], h1 = head[(size_t)(pm * 2 + 1) * FF2 + tc];
            const float w0 = cw[wcn], w1 = cw[FF2 + wcn], w2 = cw[2 * FF2 + wcn], bb = cb[wcn];
            o0[hf] = bb + w0 * hm2 + w1 * hm1 + w2 * h0; o1[hf] = bb + w0 * hm1 + w1 * h0 + w2 * h1;
        }
        ACT[(size_t)(pm * 256 + 0) * FFH + jh] = f2bf(siluf_(o0[0]) * o0[1]);
        ACT[(size_t)(pm * 256 + 1) * FFH + jh] = f2bf(siluf_(o1[0]) * o1[1]);
    }
}
constexpr int PH_PER_LAYER = 12, N_PHASES = 1 + 2 * PH_PER_LAYER;

__device__ __forceinline__ void phase_setup(const Ctx& C, int l) {
    for (int u = C.blk; u < 256; u += C.G) s5_gen_unit(C, l, u >> 3, u & 7);
    __syncthreads();
    phase_conv_a(C, l);
}
#define REOPAQUE_TID(T) int T; { unsigned z_ = (unsigned)C0.wave * 64u; asm volatile("" : "+s"(z_)); T = (int)__builtin_amdgcn_mbcnt_hi(~0u, __builtin_amdgcn_mbcnt_lo(~0u, z_)); asm volatile("" : "+v"(T)); }
__device__ __forceinline__ void run_phase(const Ctx& C0, int ph) {
    using namespace pg8;
    Ctx C = C0;
    { unsigned z_ = (unsigned)C0.wave * 64u; asm volatile("" : "+s"(z_)); int t = (int)__builtin_amdgcn_mbcnt_hi(~0u, __builtin_amdgcn_mbcnt_lo(~0u, z_)); asm volatile("" : "+v"(t)); C.tid = t; C.lane = t & 63; C.wave = __builtin_amdgcn_readfirstlane(t >> 6); }
    { CArgs* ka = (CArgs*)__builtin_amdgcn_kernarg_segment_ptr(); asm volatile("" : "+s"(ka)); C.ka = ka; C.out = ka->out; C.ws = ka->ws; }
    { int b = blockIdx.x, g = gridDim.x; asm volatile("" : "+s"(b), "+s"(g)); C.blk = b; C.G = g; }
#if TIMING
    const int sub = C.ka->sub;
#else
    const int sub = -1;
#endif
    if (ph == 0) { if (sub & 1) phase_prologue(C); __syncthreads(); if (sub & 2) { for (int u = C.blk; u < 256; u += C.G) s5_gen_unit(C, 0, u >> 3, u & 7); __syncthreads(); } if (sub & 4) phase_conv_a(C, 0); return; }
    const int l = (ph - 1) / PH_PER_LAYER, k = (ph - 1) % PH_PER_LAYER;
    bf16_t* WB = (bf16_t*)(C.ws + WS_B); bf16_t* WG = (bf16_t*)(C.ws + WS_FFW);
    float* ssq = (float*)(C.ws + WS_SSQ);
    switch (k) {
    case 0: break;
    case 1: {
        Gemm g = mkgemm((const bf16_t*)(C.ws + WS_C), 1024, WB + WB_WIN, 1024);
        const bool g256 = (C.G == 256); const bool up = C.blk >= 128;
        TileListOrder SA, SB, SC;
        SA.list = g256 ? 0x765410ull : 0xDC765410ull; SA.base.init(MTOK, (g256 ? 6 : 8) * 256, 1024, C.G, C.blk);
        if (g256) { if (up) SA.range(256 + (C.blk - 128), 0, 1); else SA.range(C.blk, 128, 2); } else SA.range(C.blk, C.G, 1 << 20);
        SB.base.init(MTOK, 4 * 256, 1024, C.G, C.blk); SB.list = 0xBA98ull; SB.range(C.blk, C.G, 1 << 20);
        SC.base.init(MTOK, 2 * 256, 1024, C.G, C.blk); SC.list = 0x32ull;
        if (g256) { if (up) SC.range(C.blk - 128, 0, 1); else SC.range(0, 0, 0); } else SC.range(C.blk, C.G, 1 << 20);
        Unit uB, uC; const bool hB = SB.next(0, uB), hC = SC.next(0, uC);
        { EpiInProj<0> E{(bf16_t*)(C.ws + WS_D), ssq, C.ka->in[13] + l * 64, C.ka->in[14] + l * 64, (float*)(C.ws + WS_KMEAN)};
          gemm_phase(C.tid, C.lds, C.ldsx, g, SA, E, uB, hB, false); }
        { EpiInProj<2> E{(bf16_t*)(C.ws + WS_D), ssq, C.ka->in[13] + l * 64, C.ka->in[14] + l * 64, (float*)(C.ws + WS_KMEAN)};
          REOPAQUE_TID(t2); gemm_phase(t2, C.lds, C.ldsx, g, SB, E, uC, hC, hB); }
        { EpiInProj<1> E{(bf16_t*)(C.ws + WS_D), ssq, C.ka->in[13] + l * 64, C.ka->in[14] + l * 64, (float*)(C.ws + WS_KMEAN)};
          REOPAQUE_TID(t3); gemm_phase(t3, C.lds, C.ldsx, g, SC, E, Unit{}, false, hB && hC); } } break;
    case 2: break;
    case 3: {
        { Gemm g = mkgemm((const bf16_t*)(C.ws + WS_D) + C_US, NNG, (const bf16_t*)(C.ws + WS_S5_BT1), 512);
          S5P1Order S{C.G, C.blk}; EpiS5P1 E{(bf16_t*)(C.ws + WS_S5_SN)};
          if (sub & 1) gemm_phase(C.tid, C.lds, C.ldsx, g, S, E); }
        __syncthreads();
        if (C.G == 256) {
            if (C.blk >= 128) { Gemm gv = mkgemm((const bf16_t*)(C.ws + WS_C), 1024, WB + WB_WIN, 1024);
                TileListOrder S; S.base.init(MTOK, 2 * 256, 1024, C.G, C.blk); S.list = 0xDCull; S.range(C.blk - 128, 0, 1);
                EpiInProj<0> E{(bf16_t*)(C.ws + WS_D), ssq, C.ka->in[13] + l * 64, C.ka->in[14] + l * 64, (float*)(C.ws + WS_KMEAN)};
                REOPAQUE_TID(tv); gemm_phase(tv, C.lds, C.ldsx, gv, S, E); }
            else if (sub & 2) for (int u = C.blk; u < 512; u += 128) ret_kv_unit(C, u >> 5, u & 31);
        } else
        if (sub & 2) for (int u = C.blk; u < 512; u += C.G) ret_kv_unit(C, u >> 5, u & 31);
        } break;
    case 4: {
        if (sub & 1) phase_select(C);
        if (C.G >= 256) { if (C.blk < 128) { if (sub & 4) s5_scan_block(C, l, C.blk >> 5, C.blk & 31); } else if (C.blk < 256) { if (sub & 2) ret_scan2(C); } }
        else { ret_scan(C);
        { const int gw = __builtin_amdgcn_readfirstlane(C.tid >> 6) * C.G + C.blk; if (gw < 128) s5_scan_unit(C, l, gw >> 5, gw & 31); } } } break;
    case 5: {
        { Gemm g = mkgemm((const bf16_t*)(C.ws + WS_D) + C_US, NNG, (const bf16_t*)(C.ws + WS_S5_BT2), 640);
          g.a[1].A = (const bf16_t*)(C.ws + WS_S5_SP); g.a[1].rs = 8192u; g.a[1].ts = 32u;
          S5P2Order S{C.G, C.blk}; EpiS5P2 E{(const bf16_t*)(C.ws + WS_D) + C_US, C.ka->in[10] + l * 512, (bf16_t*)(C.ws + WS_E)};
          if (sub & 1) gemm_phase(C.tid, C.lds, C.ldsx, g, S, E); }
        __syncthreads();
        { Ctx C2 = C; unsigned z_ = (unsigned)C0.wave * 64u; asm volatile("" : "+s"(z_)); int t = (int)__builtin_amdgcn_mbcnt_hi(~0u, __builtin_amdgcn_mbcnt_lo(~0u, z_)); asm volatile("" : "+v"(t)); C2.tid = t; C2.lane = t & 63; C2.wave = __builtin_amdgcn_readfirstlane(t >> 6);
          const attn_body::AttnTensors AT{(const bf16_t*)(C.ws + WS_D) + C_QA, (const bf16_t*)(C.ws + WS_D) + C_KA, (const bf16_t*)(C.ws + WS_D) + C_VA, (bf16_t*)(C.ws + WS_E) + 1024, (const unsigned short*)(C.ws + WS_SEL), (sub & 8) ? 0 : (1 | ((sub & 16) ? 2 : 0) | ((sub & 32) ? 4 : 0))};
          const attn_body::StaticOrder S(C2.G, C2.blk);
          if (sub & 2) attn_body::attn_phase<attn_body::StaticOrder>(C2.tid, (char*)C2.lds, AT, S); }
        __syncthreads();
        { Ctx C2 = C; unsigned z_ = (unsigned)C0.wave * 64u; asm volatile("" : "+s"(z_)); int t = (int)__builtin_amdgcn_mbcnt_hi(~0u, __builtin_amdgcn_mbcnt_lo(~0u, z_)); asm volatile("" : "+v"(t)); C2.tid = t; C2.lane = t & 63; C2.wave = __builtin_amdgcn_readfirstlane(t >> 6);
          if (!(sub & 4)) {} else if (C2.G == 256) {
              const int u0 = 4 * (C2.blk - 128), nu = C2.blk < 128 ? 0 : 4;
              for (int u = u0; u < u0 + nu; ++u) ret_out_unit(C2, l, u >> 5, u & 31);
          } else { for (int u = C2.blk; u < 512; u += C2.G) ret_out_unit(C2, l, u >> 5, u & 31); } } } break;
    case 6: {
        if (sub & 1) { if (C.G == 256) { if (C.blk >= 128) { Ctx C3 = C; C3.blk = C.blk - 128; C3.G = 128; phase_conv_b(C3, l); } } else phase_conv_b(C, l); }
        __syncthreads();
        if (sub & 2) { Gemm g = mkgemm((const bf16_t*)(C.ws + WS_E), 1536, WB + WB_WGLU, 512); StaticOrder S; S.init(MTOK, 512, 512, C.G, C.blk);
          EpiGlu E{(const bf16_t*)(C.ws + WS_E), (bf16_t*)(C.ws + WS_F)};
          gemm_phase(C.tid, C.lds, C.ldsx, g, S, E); }
        if (sub & 4) { Gemm g = mkgemm((const bf16_t*)(C.ws + WS_C), 1024, WB + WB_WIN + (size_t)NNG * 1024, 1024); StaticOrder S; S.init(MTOK, NGATE, 1024, C.G, C.blk);
          EpiScaleAct E{(bf16_t*)(C.ws + WS_D), NGATE, ssq, 0, 0, 1, 0};
          gemm_phase(C.tid, C.lds, C.ldsx, g, S, E); } } break;
    case 7: {
        Gemm g = mkgemm((const bf16_t*)(C.ws + WS_E), 1536, WB + WB_WBR, 1536); g.a[1] = rowmajor((const bf16_t*)(C.ws + WS_F), 512);
        MergeOrder S; S.base.init(MTOK, 1024, 512, C.G, C.blk);
        EpiMerge E{(const bf16_t*)(C.ws + WS_D), (bf16_t*)(C.ws + WS_C)};
        gemm_phase(C.tid, C.lds, C.ldsx, g, S, E); } break;
    case 8: {
        Gemm g = mkgemm((const bf16_t*)(C.ws + WS_C), 1024, WB + WB_WO, 1024); StaticOrder S; S.init(MTOK, 1024, 1024, C.G, C.blk);
        EpiResid E{l == 0 ? C.ka->in[0] : C.out, C.out, (bf16_t*)(C.ws + WS_E), ssq, sub == 0};
        gemm_phase(C.tid, C.lds, C.ldsx, g, S, E); } break;
    case 9: {
        Gemm g = mkgemm((const bf16_t*)(C.ws + WS_E), 1024, WG + WG_WUP, 1024); StaticOrder S; S.init(MTOK, FF2, 1024, C.G, C.blk);
        float* head = (float*)(C.ws + WS_HT); float* tail = head + (size_t)64 * 2 * FF2;
        EpiFfnUp E{(bf16_t*)(C.ws + WS_D), ssq, C.ka->in[21] + (size_t)l * 3 * FF2, C.ka->in[22] + (size_t)l * FF2, head, tail, sub == 0};
        gemm_phase(C.tid, C.lds, C.ldsx, g, S, E);
        if (l == 0 && C.G == 256 && C.blk >= 128 && sub != 0) { __syncthreads(); Ctx C3 = C; C3.blk = C.blk - 128; C3.G = 128; phase_conv_a(C3, 1); } } break;
    case 10: break;
    case 11: {
        Gemm g = mkgemm((const bf16_t*)(C.ws + WS_D), FFH, WG + WG_WD, FFH); StaticOrder S; S.init(MTOK, 1024, FFH, C.G, C.blk);
        { Unit u; for (int i = 0; S.next(i, u); ++i) fixup_tile(C, l, u.pm); }
        asm volatile("s_waitcnt vmcnt(0)" ::: "memory"); __syncthreads();
        EpiResid E{C.out, C.out, l == 0 ? (bf16_t*)(C.ws + WS_C) : nullptr, l == 0 ? ssq : nullptr, sub == 0};
        gemm_phase(C.tid, C.lds, C.ldsx, g, S, E);
        if (l == 0 && sub != 0) { __syncthreads(); if (C.G == 256) { for (int u = C.blk; u < 256; u += C.G) s5_gen_unit(C, 1, u >> 3, u & 7); } else phase_setup(C, 1); }
        } break;
    }
}

__global__ void __launch_bounds__(NTHREADS, 2) fwd_kernel(Args a) {
    extern __shared__ __attribute__((aligned(16))) unsigned char lds_raw[];
    Ctx C;
    C.lds = (LAS unsigned char*)lds_raw; C.ldsx = C.lds + RING_BYTES;
    C.tid = threadIdx.x; C.lane = C.tid & 63; C.wave = __builtin_amdgcn_readfirstlane(C.tid >> 6); C.G = gridDim.x; C.blk = blockIdx.x;
    C.ka = nullptr; C.out = nullptr; C.ws = nullptr;
#if MEGA
#if !NO_CG
    cg::grid_group grid = cg::this_grid();
#endif
    volatile LAS unsigned* bst = (volatile LAS unsigned*)(C.ldsx + 12288);
    if (threadIdx.x < 2) bst[threadIdx.x] = 0u;
    __syncthreads();
    XcdBarrier bar = xcd_barrier_post((unsigned*)a.ws, bst);
#endif
#if MEGA && NO_CG && STRAIGHT
#define PHX(k) run_phase(C, k); xcd_barrier(bar);
    PHX(0)
    PHX(2) PHX(4) PHX(5) PHX(6) PHX(7) PHX(8) PHX(9) PHX(10) PHX(12)
    PHX(14) PHX(16) PHX(17) PHX(18) PHX(19) PHX(20) PHX(21) PHX(22)
    run_phase(C, 24);
#undef PHX
#elif !MEGA && STRAIGHT
#define PHY(k) if (a.ph_lo == (k)) { run_phase(C, k); return; }
    PHY(0)
    PHY(2) PHY(4) PHY(5) PHY(6) PHY(7) PHY(8) PHY(9) PHY(10) PHY(12)
    PHY(14) PHY(16) PHY(17) PHY(18) PHY(19) PHY(20) PHY(21) PHY(22) PHY(24)
#undef PHY
#else
    for (int ph = a.ph_lo; ph < a.ph_hi; ++ph) {
        if (ph > 0 && ((ph - 1) % PH_PER_LAYER == 0 || (ph - 1) % PH_PER_LAYER == 2 || (ph - 1) % PH_PER_LAYER == 10)) continue;
        run_phase(C, ph);
#if MEGA
#if NO_CG
        if (ph + 1 < a.ph_hi) xcd_barrier(bar);
#else
        if (ph + 1 < a.ph_hi) { if (ph == a.ph_lo) grid.sync(); else xcd_barrier(bar); }
#endif
#endif
    }
#endif
}

__global__ void __launch_bounds__(NTHREADS, 2) naive_kernel(Args a, int which, int l) {
    Ctx C;
    C.lds = nullptr; C.ldsx = nullptr;
    C.tid = threadIdx.x; C.lane = C.tid & 63; C.wave = __builtin_amdgcn_readfirstlane(C.tid >> 6); C.G = gridDim.x; C.blk = blockIdx.x;
    C.ka = (CArgs*)__builtin_amdgcn_kernarg_segment_ptr(); C.out = a.out; C.ws = a.ws;
    if (which == 0) {
        const int u = __builtin_amdgcn_readfirstlane(C.tid >> 6) * C.G + C.blk;
        if (u < 128) s5_naive_unit(C, l, u >> 5, u & 31);
    } else if (which == 1) {
        const int u = __builtin_amdgcn_readfirstlane(C.tid >> 6) * C.G + C.blk;
        if (u < 32) ret_naive_unit(C, u >> 3, (u >> 1) & 3, u & 1);
        else if (u < 32 + 512) { const int v = u - 32; kmean_unit(C, v >> 7, (v >> 4) & 7, v & 15); }
    } else phase_mix3(C, l);
}
#ifdef DBG_CMP_PREP
__global__ void dbg_add_kernel(const float* v, float* out) { out[0] += 1000.f * v[0]; }
__global__ void dbg_prep_kernel(const float* x, const float* g1, const float* win, const float* qn, const float* kn, const unsigned short* P, const float* KM, float* res) {
    __shared__ float sh[64];
    const int d = threadIdx.x, idx = blockIdx.x, h = idx & 7, which = (idx >> 3) & 1, smp = idx >> 4;
    const int r = (smp * 997 + 31) & (MTOK - 1);
    float ssx = 0.f; for (int k = 0; k < 1024; ++k) { const float v = x[(size_t)r * 1024 + k]; ssx += v * v; }
    const float rs = rsqrtf(ssx / 1024.f + NORM_EPS);
    const int col = (which ? C_KA : C_QA) + h * 64 + d;
    float a = 0.f; for (int k = 0; k < 1024; ++k) a += x[(size_t)r * 1024 + k] * g1[k] * win[(size_t)k * NIN + col];
    a *= rs;
    sh[d] = a * a; __syncthreads();
    float ss = 0.f; for (int i = 0; i < 64; ++i) ss += sh[i];
    __syncthreads();
    float v = a * rsqrtf(ss / 64.f + NORM_EPS) * (which ? kn[d] : qn[d]);
    sh[d] = v; __syncthreads();
    const float t = (float)(r & (SEQ - 1));
    if (d < 16) { const int i = d & 7; const float inv = exp2f(-(float)i * (18.931568569324174f / 8.0f)); const float ang = t * inv; const float cs = cosf(ang), sn = sinf(ang);
        const float x1 = sh[i], x2 = sh[i + 8]; v = (d < 8) ? (x1 * cs - x2 * sn) : (x1 * sn + x2 * cs); }
    if (!which) v *= 0.125f * 1.4426950408889634f;
    const float st = __uint_as_float((unsigned)P[(size_t)r * NNG + col] << 16);
    float df = fabsf(v - st);
    if (which) df *= 0.18f;
    if (which && smp < 16) { const int b = smp & 3, jb = (smp >> 2) * 5; float m = 0.f;
        for (int i = 0; i < 256; ++i) m += __uint_as_float((unsigned)P[(size_t)(b * SEQ + jb * 256 + i) * NNG + C_KA + h * 64 + d] << 16);
        df = fmaxf(df, fabsf(m / 256.f - KM[((b * 8 + h) * 16 + jb) * 64 + d])); }
    sh[d] = df; __syncthreads();
    if (d == 0) { float mx = 0.f; for (int i = 0; i < 64; ++i) mx = fmaxf(mx, sh[i]); atomicMax((int*)res, __float_as_int(mx)); }
}
#endif
#if defined(DBG_CMP_RET) || defined(DBG_CMP_S5)
__global__ void dbg_add_kernel(const float* v, float* out) { out[0] += 1000.f * v[0]; }
__global__ void dbg_cmp2_kernel(const unsigned short* ya, int coff, const unsigned short* yb, int rows, float* out) {
    __shared__ float red[256];
    float m = 0.f;
    for (int i = threadIdx.x; i < rows * 512; i += 256) { const int r = i >> 9, c = i & 511;
        const float x = __uint_as_float((unsigned)ya[(size_t)r * 1536 + coff + c] << 16), y = __uint_as_float((unsigned)yb[(size_t)r * 512 + c] << 16);
        m = fmaxf(m, fabsf(x - y)); }
    red[threadIdx.x] = m; __syncthreads();
    for (int s = 128; s > 0; s >>= 1) { if (threadIdx.x < s) red[threadIdx.x] = fmaxf(red[threadIdx.x], red[threadIdx.x + s]); __syncthreads(); }
    if (threadIdx.x == 0) out[0] = red[0];
}
#endif
#ifdef DBG_CMP_MOBA
__global__ void dbg_add_kernel(const float* v, float* out) { out[0] += 1000.f * v[0]; }
__global__ void __launch_bounds__(NTHREADS, 2) dbg_moba_kernel(Args a) {
    Ctx C; C.lds = nullptr; C.ldsx = nullptr;
    C.tid = threadIdx.x; C.lane = C.tid & 63; C.wave = __builtin_amdgcn_readfirstlane(C.tid >> 6); C.G = gridDim.x; C.blk = blockIdx.x;
    C.ka = (CArgs*)__builtin_amdgcn_kernarg_segment_ptr(); C.out = a.out; C.ws = a.ws;
    const int gw = C.blk * NWAVES + __builtin_amdgcn_readfirstlane(C.tid >> 6), NGW = C.G * NWAVES;
    for (int u = gw; u < SEQ * 8; u += NGW) { const int h = u & 7, row = u >> 3; moba_naive_query(C, 0, h, row); }
}
__global__ void dbg_cmp_kernel(const unsigned short* ya, const unsigned short* yb, float* out) {
    __shared__ float red[256];
    float m = 0.f;
    for (int i = threadIdx.x; i < SEQ * 512; i += 256) { const int r = i >> 9, c = i & 511;
        const float x = __uint_as_float((unsigned)ya[(size_t)r * 1536 + 1024 + c] << 16), y = __uint_as_float((unsigned)yb[(size_t)r * 512 + c] << 16);
        m = fmaxf(m, fabsf(x - y)); }
    red[threadIdx.x] = m; __syncthreads();
    for (int s = 128; s > 0; s >>= 1) { if (threadIdx.x < s) red[threadIdx.x] = fmaxf(red[threadIdx.x], red[threadIdx.x + s]); __syncthreads(); }
    if (threadIdx.x == 0) out[0] = red[0];
}
#endif
__global__ void dbg_dump_kernel(const unsigned short* src, float* out, size_t n) {
    for (size_t i = (size_t)blockIdx.x * blockDim.x + threadIdx.x; i < n; i += (size_t)gridDim.x * blockDim.x) out[i] = __uint_as_float((unsigned)src[i] << 16);
}
extern "C" void kernel_launch(void* const* d_in, const int* in_sizes, int n_in, void* d_out, int out_size, void* d_ws, size_t ws_size, hipStream_t stream) {
    static int grid = 0;
    if (grid == 0) {
        if (n_in != 24 || out_size != MTOK * DM || ws_size < WS_END) { fprintf(stderr, "kernel_launch: unexpected shapes (n_in %d out %d ws %zu)\n", n_in, out_size, ws_size); grid = -1; return; }
        int dev = 0, cus = 0, per_cu = 0;
        hipGetDevice(&dev); hipDeviceGetAttribute(&cus, hipDeviceAttributeMultiprocessorCount, dev);
        hipFuncSetAttribute((const void*)fwd_kernel, hipFuncAttributeMaxDynamicSharedMemorySize, LDS_BYTES);
        hipOccupancyMaxActiveBlocksPerMultiprocessor(&per_cu, (const void*)fwd_kernel, NTHREADS, LDS_BYTES);
        (void)hipGetLastError();
        if (per_cu < 1) { fprintf(stderr, "kernel_launch: occupancy query says %d blocks per CU\n", per_cu); per_cu = 1; }
        grid = cus;
    }
    if (grid < 0) return;
#ifdef DBG_MEMSET
    hipMemsetAsync(d_ws, DBG_MEMSET, WS_END, stream);
#endif
    Args a{};
    for (int i = 0; i < 24; ++i) a.in[i] = (const float*)d_in[i];
    a.out = (float*)d_out; a.ws = (unsigned char*)d_ws; a.sub = -1;
#if MEGA
    hipMemsetAsync(d_ws, 0, 16384, stream);
    a.ph_lo = 0; a.ph_hi = N_PHASES;
#if NO_CG
    hipLaunchKernelGGL(fwd_kernel, dim3(grid), dim3(NTHREADS), LDS_BYTES, stream, a);
#else
    void* args[] = {&a};
    hipError_t e = hipLaunchCooperativeKernel((const void*)fwd_kernel, dim3(grid), dim3(NTHREADS), args, LDS_BYTES, stream);
    if (e != hipSuccess) fprintf(stderr, "cooperative launch failed: %s (grid %d)\n", hipGetErrorString(e), grid);
#endif
#else
#ifndef DBG_NPH
#define DBG_NPH N_PHASES
#endif
    for (int ph = 0; ph < DBG_NPH; ++ph) {
        a.ph_lo = ph; a.ph_hi = ph + 1;
        const int kk = ph == 0 ? -1 : (ph - 1) % PH_PER_LAYER, ll = ph == 0 ? 0 : (ph - 1) / PH_PER_LAYER;
        if (kk == 0 || kk == 2 || kk == 10) continue;
#ifdef DBG_CMP_S5
        if (kk == 3 && ll == 0) hipLaunchKernelGGL(naive_kernel, dim3(grid), dim3(NTHREADS), 0, stream, a, 0, ll);
#endif
#ifdef DBG_CMP_MOBA
        if (kk == 5 && ll == 0) hipLaunchKernelGGL(dbg_moba_kernel, dim3(grid), dim3(NTHREADS), 0, stream, a);
#endif
        hipLaunchKernelGGL(fwd_kernel, dim3(grid), dim3(NTHREADS), LDS_BYTES, stream, a);
#ifdef DBG_REPEAT_K
        if (kk == DBG_REPEAT_K) { Args a2 = a; a2.sub = DBG_REPEAT_SUB; for (int rep = 0; rep < DBG_REPEAT_N; ++rep) {
#ifdef DBG_REPEAT_PRE
            { Args a3 = a; a3.ph_lo = ph - 1; a3.ph_hi = ph; hipLaunchKernelGGL(fwd_kernel, dim3(grid), dim3(NTHREADS), LDS_BYTES, stream, a3); }
#endif
            hipLaunchKernelGGL(fwd_kernel, dim3(grid), dim3(NTHREADS), LDS_BYTES, stream, a2); } }
#endif
#ifdef DBG_CMP_PREP
        if (kk == 1 && ll == 0) { hipMemsetAsync(d_ws, 0, 4, stream);
            hipLaunchKernelGGL(dbg_prep_kernel, dim3(64 * 16), dim3(64), 0, stream, (const float*)d_in[0], (const float*)d_in[1], (const float*)d_in[2], (const float*)d_in[13], (const float*)d_in[14], (const unsigned short*)((unsigned char*)d_ws + WS_D), (const float*)((unsigned char*)d_ws + WS_KMEAN), (float*)d_ws); }
#endif
#ifdef DBG_CMP_S5
        if (kk == 5 && ll == 0) hipLaunchKernelGGL(dbg_cmp2_kernel, dim3(1), dim3(256), 0, stream, (const unsigned short*)((unsigned char*)d_ws + WS_E), 0, (const unsigned short*)((unsigned char*)d_ws + WS_G + 25 * MiB), 3072, (float*)d_ws);
#endif
#ifdef DBG_CMP_RET
        if (kk == 5 && ll == 0) hipLaunchKernelGGL(dbg_cmp2_kernel, dim3(1), dim3(256), 0, stream, (const unsigned short*)((unsigned char*)d_ws + WS_E), 512, (const unsigned short*)((unsigned char*)d_ws + WS_G + 25 * MiB), 3072, (float*)d_ws);
#endif
#ifdef DBG_CMP_MOBA
        if (kk == 5 && ll == 0) hipLaunchKernelGGL(dbg_cmp_kernel, dim3(1), dim3(256), 0, stream, (const unsigned short*)((unsigned char*)d_ws + WS_E), (const unsigned short*)((unsigned char*)d_ws + WS_G + 17 * MiB), (float*)d_ws);
#endif
        continue;
        hipLaunchKernelGGL(fwd_kernel, dim3(grid), dim3(NTHREADS), LDS_BYTES, stream, a);
    }
#if defined(DBG_CMP_MOBA) || defined(DBG_CMP_RET) || defined(DBG_CMP_S5) || defined(DBG_CMP_PREP)
    hipLaunchKernelGGL(dbg_add_kernel, dim3(1), dim3(1), 0, stream, (const float*)d_ws, (float*)d_out);
#endif
#ifdef DBG_DUMP_OFF
    hipLaunchKernelGGL(dbg_dump_kernel, dim3(2048), dim3(256), 0, stream, (const unsigned short*)((unsigned char*)d_ws + DBG_DUMP_OFF), (float*)d_out, (size_t)MTOK * DM);
#endif
#endif
}
```
